# Optimizing an MI355X kernel written in HIP

```python
import jax, jax.numpy as jnp
from jax import lax
import numpy as np

D_MODEL = 1024
BATCH = 32
SEQ = 2048
DEPTH = 1
DEC_BATCH = 16
DEC_SEQ = 2048
PAST_LEN = 128

EPS = 1e-6
GLA_HEADS = 4
GLA_DK = 128
GLA_DV = 256
GLA_QK = GLA_HEADS * GLA_DK
GLA_VW = GLA_HEADS * GLA_DV
GLA_RANK = 16
GLA_TEMP = 16.0
GLA_CHUNK = 64
MLA_HEADS = 8
MLA_Q_RANK = 256
MLA_KV_RANK = 256
MLA_NOPE = 128
MLA_ROPE = 64
MLA_V = 128
MLA_VW = MLA_HEADS * MLA_V
ROPE_BASE = 10000.0
Q_BLOCK = 128
D_FF = ((8 * D_MODEL + 3 * 256 - 1) // (3 * 256)) * 256
IN_WIDTHS = (GLA_QK, GLA_QK, GLA_VW, GLA_VW, GLA_RANK, GLA_RANK,
             MLA_Q_RANK, MLA_KV_RANK, MLA_ROPE, D_MODEL, D_MODEL)
D_IN = 2 * GLA_QK + 2 * GLA_VW + 2 * GLA_RANK + MLA_Q_RANK + MLA_KV_RANK + MLA_ROPE + 2 * D_MODEL

kernel_name = "hybrid_gla_mla_gated_encoder"


def rms_norm(x, g):
    xf = x.astype(jnp.float32)
    y = xf * lax.rsqrt(jnp.mean(xf * xf, axis=-1, keepdims=True) + EPS)
    return (y * g.astype(jnp.float32)).astype(x.dtype)


def rope_tables(L):
    inv = ROPE_BASE ** (-jnp.arange(0, MLA_ROPE, 2, dtype=jnp.float32) / MLA_ROPE)
    ang = jnp.arange(L, dtype=jnp.float32)[:, None] * inv[None, :]
    return jnp.cos(ang), jnp.sin(ang)


def apply_rope(x, cos, sin):
    x1, x2 = jnp.split(x.astype(jnp.float32), 2, axis=-1)
    return jnp.concatenate([x1 * cos - x2 * sin, x1 * sin + x2 * cos], axis=-1).astype(x.dtype)


def gla_scan(q, k, v, log_a):
    B, L = q.shape[0], q.shape[1]
    nc = L // GLA_CHUNK

    def chunks(t):
        return t.astype(jnp.float32).reshape(B, nc, GLA_CHUNK, GLA_HEADS, t.shape[-1]).transpose(1, 0, 3, 2, 4)

    qc, kc, vc, ac = chunks(q), chunks(k), chunks(v), chunks(log_a)
    b = jnp.cumsum(ac, axis=3)
    b_end = b[:, :, :, -1:, :]
    q_dec = qc * jnp.exp(b)
    k_inv = kc * jnp.exp(-b)
    k_end = kc * jnp.exp(b_end - b)
    mask = jnp.tril(jnp.ones((GLA_CHUNK, GLA_CHUNK), dtype=bool))
    scores = jnp.einsum('nbhid,nbhjd->nbhij', q_dec, k_inv)
    o_intra = jnp.einsum('nbhij,nbhje->nbhie', jnp.where(mask, scores, 0.0), vc)

    def step(S, inp):
        q_n, k_n, v_n, dec_n = inp
        o_n = jnp.einsum('bhid,bhde->bhie', q_n, S)
        S = dec_n[..., None] * S + jnp.einsum('bhjd,bhje->bhde', k_n, v_n)
        return S, o_n

    S0 = jnp.zeros((B, GLA_HEADS, GLA_DK, GLA_DV), jnp.float32)
    _, o_inter = lax.scan(step, S0, (q_dec, k_end, vc, jnp.exp(b_end[:, :, :, 0, :])))
    o = o_intra + o_inter
    return o.transpose(1, 0, 3, 2, 4).reshape(B, L, GLA_HEADS, GLA_DV)


def gla_branch(q_raw, k_raw, v_raw, g_raw, af_raw, ab_raw, p):
    B, L = q_raw.shape[0], q_raw.shape[1]
    q = q_raw.reshape(B, L, GLA_HEADS, GLA_DK) * (GLA_DK ** -0.5)
    k = k_raw.reshape(B, L, GLA_HEADS, GLA_DK)
    v = v_raw.reshape(B, L, GLA_HEADS, GLA_DV)
    z_f = af_raw @ p['gla_wa_fwd'] + p['gla_ba_fwd']
    z_b = ab_raw @ p['gla_wa_bwd'] + p['gla_ba_bwd']
    log_a_f = (jax.nn.log_sigmoid(z_f.astype(jnp.float32)) / GLA_TEMP).reshape(B, L, GLA_HEADS, GLA_DK)
    log_a_b = (jax.nn.log_sigmoid(z_b.astype(jnp.float32)) / GLA_TEMP).reshape(B, L, GLA_HEADS, GLA_DK)
    o_f = gla_scan(q, k, v, log_a_f)
    o_b = gla_scan(q[:, ::-1], k[:, ::-1], v[:, ::-1], log_a_b[:, ::-1])[:, ::-1]
    o = rms_norm(o_f + o_b, p['gla_norm']).astype(q_raw.dtype)
    o = o.reshape(B, L, GLA_VW) * jax.nn.silu(g_raw)
    return o @ p['w_o_gla']


def mla_branch(cq_raw, ckv_raw, kr_raw, p):
    B, L = cq_raw.shape[0], cq_raw.shape[1]
    cos, sin = rope_tables(L)
    c_q = rms_norm(cq_raw, p['mla_norm_q'])
    q = (c_q @ p['w_uq']).reshape(B, L, MLA_HEADS, MLA_NOPE + MLA_ROPE)
    q_nope, q_pe = q[..., :MLA_NOPE], q[..., MLA_NOPE:]
    q_pe = apply_rope(q_pe, cos[:, None, :], sin[:, None, :])
    c_kv = rms_norm(ckv_raw, p['mla_norm_kv'])
    k_nope = (c_kv @ p['w_uk']).reshape(B, L, MLA_HEADS, MLA_NOPE)
    v = (c_kv @ p['w_uv']).reshape(B, L, MLA_HEADS, MLA_V)
    k_pe = apply_rope(kr_raw, cos, sin)
    scale = (MLA_NOPE + MLA_ROPE) ** -0.5
    nb = L // Q_BLOCK
    qn_b = q_nope.reshape(B, nb, Q_BLOCK, MLA_HEADS, MLA_NOPE).transpose(1, 0, 2, 3, 4)
    qp_b = q_pe.reshape(B, nb, Q_BLOCK, MLA_HEADS, MLA_ROPE).transpose(1, 0, 2, 3, 4)

    def attend(blk):
        qn, qp = blk
        s = jnp.einsum('bqhd,bkhd->bhqk', qn, k_nope) + jnp.einsum('bqhr,bkr->bhqk', qp, k_pe)
        pr = jax.nn.softmax(s.astype(jnp.float32) * scale, axis=-1).astype(v.dtype)
        return jnp.einsum('bhqk,bkhe->bqhe', pr, v)

    o = lax.map(attend, (qn_b, qp_b))
    o = o.transpose(1, 0, 2, 3, 4).reshape(B, L, MLA_VW)
    return o @ p['w_o_mla']


def encoder_layer(x, p):
    h = rms_norm(x, p['norm_mix_pre'])
    split_idx = np.cumsum(IN_WIDTHS)[:-1].tolist()
    (q_raw, k_raw, v_raw, g_raw, af_raw, ab_raw,
     cq_raw, ckv_raw, kr_raw, gate_a, gate_b) = jnp.split(h @ p['w_in'], split_idx, axis=-1)
    y_a = gla_branch(q_raw, k_raw, v_raw, g_raw, af_raw, ab_raw, p)
    y_b = mla_branch(cq_raw, ckv_raw, kr_raw, p)
    merged = jax.nn.sigmoid(gate_a) * y_a + jax.nn.sigmoid(gate_b) * y_b
    x = x + rms_norm(merged @ p['w_out'], p['norm_mix_post'])
    h = rms_norm(x, p['norm_ffn_pre'])
    f = (jax.nn.silu(h @ p['w_gate']) * (h @ p['w_up'])) @ p['w_down']
    return x + rms_norm(f, p['norm_ffn_post'])


def _w(key, shape, fan_in):
    return jax.random.normal(key, shape, jnp.float32) * (fan_in ** -0.5)


def _gain(key, shape):
    return 1.0 + 0.02 * jax.random.normal(key, shape, jnp.float32)


def _bias(key, shape):
    return 0.1 * jax.random.normal(key, shape, jnp.float32)


def setup_inputs(seed: int = 0) -> dict:
    key = jax.random.key(seed)
    ks = jax.random.split(key, 24)
    L = DEPTH
    return {
        'x_prompt': jax.random.normal(ks[0], (BATCH, SEQ, D_MODEL), jnp.float32),
        'x_sample': jax.random.normal(ks[1], (DEC_BATCH, DEC_SEQ, D_MODEL), jnp.float32),
        'norm_mix_pre': _gain(ks[2], (L, D_MODEL)),
        'w_in': _w(ks[3], (L, D_MODEL, D_IN), D_MODEL),
        'gla_wa_fwd': _w(ks[4], (L, GLA_RANK, GLA_QK), GLA_RANK),
        'gla_ba_fwd': _bias(ks[5], (L, GLA_QK)),
        'gla_wa_bwd': _w(ks[6], (L, GLA_RANK, GLA_QK), GLA_RANK),
        'gla_ba_bwd': _bias(ks[7], (L, GLA_QK)),
        'gla_norm': _gain(ks[8], (L, GLA_DV)),
        'w_o_gla': _w(ks[9], (L, GLA_VW, D_MODEL), GLA_VW),
        'mla_norm_q': _gain(ks[10], (L, MLA_Q_RANK)),
        'w_uq': _w(ks[11], (L, MLA_Q_RANK, MLA_HEADS * (MLA_NOPE + MLA_ROPE)), MLA_Q_RANK),
        'mla_norm_kv': _gain(ks[12], (L, MLA_KV_RANK)),
        'w_uk': _w(ks[13], (L, MLA_KV_RANK, MLA_HEADS * MLA_NOPE), MLA_KV_RANK),
        'w_uv': _w(ks[14], (L, MLA_KV_RANK, MLA_HEADS * MLA_V), MLA_KV_RANK),
        'w_o_mla': _w(ks[15], (L, MLA_VW, D_MODEL), MLA_VW),
        'w_out': _w(ks[16], (L, D_MODEL, D_MODEL), D_MODEL),
        'norm_mix_post': _gain(ks[17], (L, D_MODEL)),
        'norm_ffn_pre': _gain(ks[18], (L, D_MODEL)),
        'w_gate': _w(ks[19], (L, D_MODEL, D_FF), D_MODEL),
        'w_up': _w(ks[20], (L, D_MODEL, D_FF), D_MODEL),
        'w_down': _w(ks[21], (L, D_FF, D_MODEL), D_FF),
        'norm_ffn_post': _gain(ks[22], (L, D_MODEL)),
    }


def reference(x_prompt, x_sample, norm_mix_pre, w_in, gla_wa_fwd, gla_ba_fwd, gla_wa_bwd,
              gla_ba_bwd, gla_norm, w_o_gla, mla_norm_q, w_uq, mla_norm_kv, w_uk, w_uv,
              w_o_mla, w_out, norm_mix_post, norm_ffn_pre, w_gate, w_up, w_down, norm_ffn_post):
    params = dict(norm_mix_pre=norm_mix_pre, w_in=w_in, gla_wa_fwd=gla_wa_fwd,
                  gla_ba_fwd=gla_ba_fwd, gla_wa_bwd=gla_wa_bwd, gla_ba_bwd=gla_ba_bwd,
                  gla_norm=gla_norm, w_o_gla=w_o_gla, mla_norm_q=mla_norm_q, w_uq=w_uq,
                  mla_norm_kv=mla_norm_kv, w_uk=w_uk, w_uv=w_uv, w_o_mla=w_o_mla,
                  w_out=w_out, norm_mix_post=norm_mix_post, norm_ffn_pre=norm_ffn_pre,
                  w_gate=w_gate, w_up=w_up, w_down=w_down, norm_ffn_post=norm_ffn_post)

    def trunk(x):
        for layer in range(DEPTH):
            x = encoder_layer(x, {name: arr[layer] for name, arr in params.items()})
        return x

    y_prompt = trunk(x_prompt)
    y_sample = trunk(x_sample)
    return (y_prompt, y_sample)
```

```cpp
#include <hip/hip_runtime.h>
#include <hip/hip_cooperative_groups.h>
#include <cstdio>
#include <cstdint>
#include <cmath>
namespace cg = cooperative_groups;

constexpr int DM = 1024, SEQ = 2048, NB_TOTAL = 48, TTOT = NB_TOTAL * SEQ;
constexpr int GB = 16, GT = GB * SEQ, NGROUP = NB_TOTAL / GB;
constexpr int D_IN = 5728, NINP = 5888;
constexpr int GQK = 512, GVW = 1024, GH = 4, GDK = 128, GDV = 256, GRANK = 16, GCH = 64;
constexpr int MH = 8, MQR = 256, MNOPE = 128, MROPE = 64, MQD = 192, MV_ = 128;
constexpr int DFF = 2816;
constexpr float EPS = 1e-6f;
constexpr size_t MiB = 1u << 20;
constexpr size_t WS_CTL = 0;
constexpr size_t WS_ROPE = 256 * 1024;
constexpr size_t WS_W = 1 * MiB;
constexpr size_t W_IN = WS_W;
constexpr size_t W_UQ = W_IN + (size_t)NINP * DM * 2;
constexpr size_t W_UKV = W_UQ + (size_t)1536 * 256 * 2;
constexpr size_t W_OGLA = W_UKV + (size_t)2048 * 256 * 2;
constexpr size_t W_OMLA = W_OGLA + (size_t)DM * DM * 2;
constexpr size_t W_OUT = W_OMLA + (size_t)DM * DM * 2;
constexpr size_t W_GU = W_OUT + (size_t)DM * DM * 2;
constexpr size_t W_DOWN = W_GU + (size_t)2 * DFF * DM * 2;
constexpr size_t W_END = W_DOWN + (size_t)DM * DFF * 2;
static_assert(W_END <= 44 * MiB, "weights region");
constexpr size_t WS_STAT = 44 * MiB;
constexpr size_t WS_PMISC = 46 * MiB;
constexpr size_t WS_H = 48 * MiB;
constexpr size_t WS_P = 112 * MiB;
constexpr size_t P_Q = WS_P, P_K = WS_P + 32 * MiB, P_V = WS_P + 64 * MiB, P_G = WS_P + 128 * MiB, P_GA = WS_P + 192 * MiB, P_GB = WS_P + 256 * MiB;
constexpr size_t P_CQ = WS_P + 320 * MiB, P_CKV = WS_P + 336 * MiB;
constexpr size_t WS_MQ = 464 * MiB;
constexpr size_t WS_MK = 560 * MiB;
constexpr size_t WS_MV = 656 * MiB;
constexpr size_t WS_MO = 720 * MiB;
constexpr size_t WS_GOF = 784 * MiB;
constexpr size_t WS_GOB = 848 * MiB;
constexpr size_t WS_HX = 912 * MiB;
constexpr size_t WS_END = 976 * MiB;
constexpr size_t WS_MERGED = P_V;
constexpr size_t WS_U = WS_MQ;
constexpr size_t WS_A = WS_P;
constexpr size_t WS_F = WS_H;

#define LAS __attribute__((address_space(3)))
typedef unsigned short bf16_t;
typedef short bf16x8 __attribute__((ext_vector_type(8)));
typedef short s16x4 __attribute__((ext_vector_type(4)));
typedef float f32x4 __attribute__((ext_vector_type(4)));
typedef float f32x2 __attribute__((ext_vector_type(2)));
typedef float f32x16 __attribute__((ext_vector_type(16)));
typedef unsigned u32x4 __attribute__((ext_vector_type(4)));
typedef unsigned u32x2 __attribute__((ext_vector_type(2)));

__device__ __forceinline__ float bf2f(unsigned b) { return __uint_as_float(b << 16); }
__device__ __forceinline__ float bflo(unsigned w) { return __uint_as_float(w << 16); }
__device__ __forceinline__ float bfhi(unsigned w) { return __uint_as_float(w & 0xffff0000u); }
__device__ __forceinline__ unsigned cvtpk(float lo, float hi) { unsigned r; asm volatile("v_cvt_pk_bf16_f32 %0, %1, %2" : "=v"(r) : "v"(lo), "v"(hi)); return r; }
typedef __bf16 bf16x2_t __attribute__((ext_vector_type(2)));
__device__ __forceinline__ unsigned cvtpk_c(float lo, float hi) { f32x2 v = {lo, hi}; bf16x2_t b = __builtin_convertvector(v, bf16x2_t); return __builtin_bit_cast(unsigned, b); }
__device__ __forceinline__ float fsigmoid(float x) { return __builtin_amdgcn_rcpf(1.0f + __builtin_amdgcn_exp2f(x * -1.4426950408889634f)); }
template <int CTRL> __device__ __forceinline__ float dppx(float v) { return __int_as_float(__builtin_amdgcn_update_dpp(0, __float_as_int(v), CTRL, 0xf, 0xf, true)); }
__device__ __forceinline__ float xor16(float v) { return __int_as_float(__builtin_amdgcn_ds_swizzle(__float_as_int(v), 0x401F)); }
__device__ __forceinline__ float sum_xor32(float v) { auto rr = __builtin_amdgcn_permlane32_swap(__float_as_uint(v), __float_as_uint(v), false, false); return __uint_as_float(rr[0]) + __uint_as_float(rr[1]); }
__device__ __forceinline__ float red16(float v) { v += dppx<0xB1>(v); v += dppx<0x4E>(v); v += dppx<0x141>(v); v += dppx<0x140>(v); return v; }
__device__ __forceinline__ float wave_sum(float v) { v = red16(v); v += xor16(v); return sum_xor32(v); }

__device__ __forceinline__ int lane_now() { int l; asm volatile("v_mbcnt_lo_u32_b32 %0, -1, 0\n\tv_mbcnt_hi_u32_b32 %0, -1, %0" : "=v"(l)); return l; }

struct KArgs {
    const float* in[23];
    float* out;
    unsigned char* ws;
    double inv_freq[32];
};
namespace pg8 {
#define PG8_LAS __attribute__((address_space(3)))
typedef unsigned short bf16_t;
typedef short bf16x8 __attribute__((ext_vector_type(8)));
typedef float f32x4 __attribute__((ext_vector_type(4)));
typedef unsigned u32x4 __attribute__((ext_vector_type(4)));
constexpr int BM = 256, BK = 64, HALF = 128, HTB = HALF * BK * 2  , STAGE_BYTES = 8 * HTB, NXCD = 8, WGM = 8;

__host__ __device__ __forceinline__ int lds_byte(int r, int c) { const int st = (r >> 4) * 2 + (c >> 5), rr = r & 15, cc = c & 31, ob = rr * 64 + cc * 2; return st * 1024 + (ob ^ (((ob >> 9) & 1) << 5)); }
__host__ __device__ __forceinline__ void stage_rc(int b, int& R, int& C) { const int st = b / 1024, sb = b % 1024, swz = sb ^ (((sb >> 9) & 1) << 5); R = (st >> 1) * 16 + swz / 64; C = (st & 1) * 32 + (swz % 64) / 2; }
__host__ __device__ __forceinline__ int perm32(int rho) { const int n = rho >> 4, i = rho & 15; return 8 * (i >> 2) + 4 * n + (i & 3); }

struct Unit { int pm, pn; };
struct Gemm { const bf16_t* A; const bf16_t* Bt; int M, N, K, lda, ldb; };

struct StaticOrder {
    int nM, nN, nwg, G, c;
    __host__ __device__ void init(int M, int N, int G_, int c_) { nM = M / BM; nN = N / BM; nwg = nM * nN; G = G_; c = c_; }
    __host__ __device__ bool next(int i, Unit& u) const {
        const long L = (long)i * G + c; if (L >= nwg) return false;
        int wgid = (int)L; { const int q = nwg / NXCD, r = nwg % NXCD, xcd = wgid % NXCD, off = wgid / NXCD; wgid = (xcd < r ? xcd * (q + 1) : r * (q + 1) + (xcd - r) * q) + off; }
        const int nig = WGM * nN, gid = wgid / nig, fm = gid * WGM, gsz = (nM - fm) < WGM ? (nM - fm) : WGM;
        u.pm = fm + ((wgid % nig) % gsz); u.pn = (wgid % nig) / gsz; return true;
    }
    __device__ __forceinline__ void a_ready(const Unit&) const {}
    __device__ __forceinline__ void done(const Unit&) const {}
};
__device__ __forceinline__ unsigned cvt_pk_bf16(float lo, float hi) { unsigned r; asm volatile("v_cvt_pk_bf16_f32 %0, %1, %2" : "=v"(r) : "v"(lo), "v"(hi)); return r; }

__device__ __forceinline__ u32x4 pack8(f32x4 v0, f32x4 v1) { u32x4 w; w.x = cvt_pk_bf16(v0[0], v0[1]); w.y = cvt_pk_bf16(v0[2], v0[3]); w.z = cvt_pk_bf16(v1[0], v1[1]); w.w = cvt_pk_bf16(v1[2], v1[3]); return w; }
__device__ __forceinline__ void rope4(f32x4& x, f32x4 cs) {
    const float a0 = x[0] * cs[0] - x[1] * cs[1], a1 = x[0] * cs[1] + x[1] * cs[0], b0 = x[2] * cs[2] - x[3] * cs[3], b1 = x[2] * cs[3] + x[3] * cs[2];
    x = (f32x4){a0, a1, b0, b1};
}

struct EpiInProj {
    static constexpr bool PERM = true, AFTER_DRAIN = false;
    unsigned char* ws;
    __device__ __forceinline__ void operator()(const f32x4 (&acc)[2][2][4][2], const Unit& u, int wr, int wc, int fr, int fq) const {
        const int pn = u.pn, row0 = u.pm * BM + wr * 64 + fr, cin = wc * 32 + 8 * fq;
        if (pn < 22) {
            bf16_t* base; int ldc, col;
            if (pn < 4) { base = (bf16_t*)(ws + P_Q + (size_t)(pn >> 1) * 32 * MiB); ldc = 512; col = (pn & 1) * 256; }
            else if (pn < 20) { base = (bf16_t*)(ws + P_V + (size_t)((pn - 4) >> 2) * 64 * MiB); ldc = 1024; col = ((pn - 4) & 3) * 256; }
            else { base = (bf16_t*)(ws + P_CQ + (size_t)(pn - 20) * 16 * MiB); ldc = 256; col = 0; }
#pragma unroll
            for (int ai = 0; ai < 2; ++ai)
#pragma unroll
                for (int m = 0; m < 4; ++m) { bf16_t* rowp = base + (size_t)(row0 + ai * HALF + m * 16) * ldc + col + cin;
#pragma unroll
                    for (int bj = 0; bj < 2; ++bj) *(u32x4*)(rowp + bj * HALF) = pack8(acc[ai][bj][m][0], acc[ai][bj][m][1]);
                    asm volatile("" ::: "memory"); }
            if (pn >= 20) {
                float* st = (float*)(ws + WS_STAT) + (size_t)(pn - 20) * GT * 4;
#pragma unroll
                for (int ai = 0; ai < 2; ++ai)
#pragma unroll
                    for (int m = 0; m < 4; ++m) { float s = 0.f;
#pragma unroll
                        for (int bj = 0; bj < 2; ++bj)
#pragma unroll
                            for (int n = 0; n < 2; ++n) { const f32x4 x = acc[ai][bj][m][n]; s += (x[0] * x[0] + x[1] * x[1]) + (x[2] * x[2] + x[3] * x[3]); }
                        s += xor16(s); s = sum_xor32(s);
                        if (fq == 0) st[(size_t)(row0 + ai * HALF + m * 16) * 4 + wc] = s; asm volatile("" ::: "memory"); }
            }
        } else {
            if (wc == 0) {
                bf16_t* pm_ = (bf16_t*)(ws + WS_PMISC);
#pragma unroll
                for (int ai = 0; ai < 2; ++ai)
#pragma unroll
                    for (int m = 0; m < 4; ++m) *(u32x4*)(pm_ + (size_t)(row0 + ai * HALF + m * 16) * 32 + 8 * fq) = pack8(acc[ai][0][m][0], acc[ai][0][m][1]);
            } else if (wc < 3) {
                const int s0 = (wc - 1) * 32 + 8 * fq;
                const float* rt = (const float*)(ws + WS_ROPE);
                bf16_t* mk = (bf16_t*)(ws + WS_MK);
#pragma unroll
                for (int ai = 0; ai < 2; ++ai)
#pragma unroll
                    for (int m = 0; m < 4; ++m) { const int row = row0 + ai * HALF + m * 16, pos = row & (SEQ - 1);
                        const f32x4 cs0 = *(const f32x4*)(rt + (size_t)pos * 64 + s0), cs1 = *(const f32x4*)(rt + (size_t)pos * 64 + s0 + 4);
                        f32x4 v0 = acc[ai][0][m][0], v1 = acc[ai][0][m][1]; rope4(v0, cs0); rope4(v1, cs1);
                        const u32x4 w = pack8(v0, v1);
#pragma unroll
                        for (int h = 0; h < MH; ++h) *(u32x4*)(mk + (size_t)row * (MH * MQD) + h * MQD + MNOPE + s0) = w;
                        asm volatile("" ::: "memory"); }
            }
        }
    }
};

__device__ __forceinline__ float row_rstd(const float* st, int row, float invn) { const f32x4 p = *(const f32x4*)(st + (size_t)row * 4); return 1.0f / sqrtf(((p[0] + p[1]) + (p[2] + p[3])) * invn + EPS); }

struct EpiMlaQ {
    static constexpr bool PERM = true, AFTER_DRAIN = false;
    unsigned char* ws;
    __device__ __forceinline__ void operator()(const f32x4 (&acc)[2][2][4][2], const Unit& u, int wr, int wc, int fr, int fq) const {
        const int row0 = u.pm * BM + wr * 64 + fr;
        const float* rt = (const float*)(ws + WS_ROPE);
        bf16_t* mq = (bf16_t*)(ws + WS_MQ);
        const int cb0 = u.pn * BM + wc * 32 + 8 * fq, w0 = cb0 % MQD, w1 = (cb0 + HALF) % MQD;
        const int rbj = (w0 >= MNOPE) ? 0 : ((w1 >= MNOPE) ? 1 : -1);
        const int s0 = (rbj == 0 ? w0 : w1) - MNOPE;
#pragma unroll
        for (int ai = 0; ai < 2; ++ai)
#pragma unroll
            for (int mh = 0; mh < 2; ++mh) {
                f32x4 cs[2][2];
                if (rbj >= 0) {
#pragma unroll
                    for (int mm = 0; mm < 2; ++mm) { const int pos = (row0 + ai * HALF + (2 * mh + mm) * 16) & (SEQ - 1); cs[mm][0] = *(const f32x4*)(rt + (size_t)pos * 64 + s0); cs[mm][1] = *(const f32x4*)(rt + (size_t)pos * 64 + s0 + 4); }
                }
#pragma unroll
                for (int mm = 0; mm < 2; ++mm) { const int m = 2 * mh + mm, row = row0 + ai * HALF + m * 16;
#pragma unroll
                    for (int bj = 0; bj < 2; ++bj) { const int c0 = cb0 + bj * HALF;
                        f32x4 v0 = acc[ai][bj][m][0], v1 = acc[ai][bj][m][1];
                        if (bj == rbj) { rope4(v0, cs[mm][0]); rope4(v1, cs[mm][1]); }
                        *(u32x4*)(mq + (size_t)row * (MH * MQD) + c0) = pack8(v0, v1); } }
                asm volatile("" ::: "memory");
            }
    }
};

struct EpiMlaKV {
    static constexpr bool PERM = true, AFTER_DRAIN = false;
    unsigned char* ws;
    __device__ __forceinline__ void operator()(const f32x4 (&acc)[2][2][4][2], const Unit& u, int wr, int wc, int fr, int fq) const {
        const int row0 = u.pm * BM + wr * 64 + fr;
        const float* st = (const float*)(ws + WS_STAT) + (size_t)GT * 4;
        bf16_t* mk = (bf16_t*)(ws + WS_MK); bf16_t* mv = (bf16_t*)(ws + WS_MV);
#pragma unroll
        for (int ai = 0; ai < 2; ++ai) {
            f32x4 sp[4];
#pragma unroll
            for (int m = 0; m < 4; ++m) sp[m] = *(const f32x4*)(st + (size_t)(row0 + ai * HALF + m * 16) * 4);
#pragma unroll
            for (int m = 0; m < 4; ++m) { const int row = row0 + ai * HALF + m * 16; const f32x4 p = sp[m];
                const float rs = 1.0f / sqrtf(((p[0] + p[1]) + (p[2] + p[3])) * (1.0f / 256.0f) + EPS);
#pragma unroll
                for (int bj = 0; bj < 2; ++bj) { const int c0 = u.pn * BM + bj * HALF + wc * 32 + 8 * fq;
                    const u32x4 w = pack8(acc[ai][bj][m][0] * rs, acc[ai][bj][m][1] * rs);
                    if (u.pn < 4) *(u32x4*)(mk + (size_t)row * (MH * MQD) + (c0 >> 7) * MQD + (c0 & 127)) = w;
                    else *(u32x4*)(mv + (size_t)row * 1024 + (c0 - 1024)) = w; } }
            asm volatile("" ::: "memory");
        }
    }
};

template <int SECOND> struct EpiGate {
    static constexpr bool PERM = true, AFTER_DRAIN = false;
    const bf16_t* gate; bf16_t* out;
    __device__ __forceinline__ void operator()(const f32x4 (&acc)[2][2][4][2], const Unit& u, int wr, int wc, int fr, int fq) const {
        const int row0 = u.pm * BM + wr * 64 + fr, col0 = u.pn * BM + wc * 32 + 8 * fq;
#pragma unroll
        for (int ai = 0; ai < 2; ++ai)
#pragma unroll
            for (int mh = 0; mh < 2; ++mh) {
                u32x4 g[2][2], p[2][2];
#pragma unroll
                for (int mm = 0; mm < 2; ++mm)
#pragma unroll
                    for (int bj = 0; bj < 2; ++bj) { const size_t off = (size_t)(row0 + ai * HALF + (2 * mh + mm) * 16) * 1024 + col0 + bj * HALF;
                        g[mm][bj] = *(const u32x4*)(gate + off); if (SECOND) p[mm][bj] = *(const u32x4*)(out + off); }
#pragma unroll
                for (int mm = 0; mm < 2; ++mm)
#pragma unroll
                    for (int bj = 0; bj < 2; ++bj) { const int m = 2 * mh + mm; const size_t off = (size_t)(row0 + ai * HALF + m * 16) * 1024 + col0 + bj * HALF;
                        const u32x4 gg = g[mm][bj];
                        f32x4 v0 = acc[ai][bj][m][0], v1 = acc[ai][bj][m][1];
                        v0[0] *= fsigmoid(bflo(gg.x)); v0[1] *= fsigmoid(bfhi(gg.x)); v0[2] *= fsigmoid(bflo(gg.y)); v0[3] *= fsigmoid(bfhi(gg.y));
                        v1[0] *= fsigmoid(bflo(gg.z)); v1[1] *= fsigmoid(bfhi(gg.z)); v1[2] *= fsigmoid(bflo(gg.w)); v1[3] *= fsigmoid(bfhi(gg.w));
                        if (SECOND) { const u32x4 pp = p[mm][bj];
                            v0[0] += bflo(pp.x); v0[1] += bfhi(pp.x); v0[2] += bflo(pp.y); v0[3] += bfhi(pp.y); v1[0] += bflo(pp.z); v1[1] += bfhi(pp.z); v1[2] += bflo(pp.w); v1[3] += bfhi(pp.w); }
                        *(u32x4*)(out + off) = pack8(v0, v1); }
            }
    }
};

struct EpiF32 {
    static constexpr bool PERM = false, AFTER_DRAIN = false;
    float* C; int ldc;
    __device__ __forceinline__ void operator()(const f32x4 (&acc)[2][2][4][2], const Unit& u, int wr, int wc, int fr, int fq) const {
        const int row0 = u.pm * BM + wr * 64 + fr, col0 = u.pn * BM + wc * 32 + 4 * fq;
#pragma unroll
        for (int ai = 0; ai < 2; ++ai)
#pragma unroll
            for (int m = 0; m < 4; ++m) { float* rowp = C + (size_t)(row0 + ai * HALF + m * 16) * ldc + col0;
#pragma unroll
                for (int bj = 0; bj < 2; ++bj)
#pragma unroll
                    for (int n = 0; n < 2; ++n) *(f32x4*)(rowp + bj * HALF + n * 16) = acc[ai][bj][m][n]; }
    }
};

struct EpiSwiGLU {
    static constexpr bool PERM = true, AFTER_DRAIN = false;
    bf16_t* out;
    __device__ __forceinline__ void operator()(const f32x4 (&acc)[2][2][4][2], const Unit& u, int wr, int wc, int fr, int fq) const {
        const int row0 = u.pm * BM + wr * 64 + fr, oc0 = (u.pn * BM + wc * 32 + 8 * fq) >> 1;
#pragma unroll
        for (int ai = 0; ai < 2; ++ai)
#pragma unroll
            for (int m = 0; m < 4; ++m) { bf16_t* rowp = out + (size_t)(row0 + ai * HALF + m * 16) * DFF + oc0;
#pragma unroll
                for (int bj = 0; bj < 2; ++bj) { const f32x4 v0 = acc[ai][bj][m][0], v1 = acc[ai][bj][m][1];
                    const float o0 = v0[0] * fsigmoid(v0[0]) * v0[1], o1 = v0[2] * fsigmoid(v0[2]) * v0[3], o2 = v1[0] * fsigmoid(v1[0]) * v1[1], o3 = v1[2] * fsigmoid(v1[2]) * v1[3];
                    u32x2 w; w.x = cvt_pk_bf16(o0, o1); w.y = cvt_pk_bf16(o2, o3);
                    *(u32x2*)(rowp + bj * (HALF / 2)) = w; }
                asm volatile("" ::: "memory"); }
    }
};

struct EpiBf16Plain {
    static constexpr bool PERM = true, AFTER_DRAIN = false;
    bf16_t* C; int ldc;
    __device__ __forceinline__ void operator()(const f32x4 (&acc)[2][2][4][2], const Unit& u, int wr, int wc, int fr, int fq) const {
        const int row0 = u.pm * BM + wr * 64 + fr, col0 = u.pn * BM + wc * 32 + 8 * fq;
#pragma unroll
        for (int ai = 0; ai < 2; ++ai)
#pragma unroll
            for (int m = 0; m < 4; ++m) { bf16_t* rowp = C + (size_t)(row0 + ai * HALF + m * 16) * ldc + col0;
#pragma unroll
                for (int bj = 0; bj < 2; ++bj) *(u32x4*)(rowp + bj * HALF) = pack8(acc[ai][bj][m][0], acc[ai][bj][m][1]); }
    }
};
template <class Epi, class Sched, bool ALIGN_EPI = false, bool SP2 = false>
__device__ __forceinline__ void gemm_phase(PG8_LAS unsigned char* lds, const Gemm g, const Sched& S, const Epi& E, int tid_in) {
    int tid_o = tid_in; asm volatile("" : "+v"(tid_o));
    const int tid = tid_o, wid = __builtin_amdgcn_readfirstlane(tid >> 6), lane = tid & 63, wr = wid >> 2, wc = wid & 3, fr = lane & 15, fq = lane >> 4;
    const int K = g.K, nt = K / BK, lda = g.lda, ldb = g.ldb;
    unsigned voffA[2], voffB[2];
#pragma unroll
    for (int i = 0; i < 2; ++i) { int R, C; stage_rc(tid * 16 + i * 8192, R, C); const int Rb = Epi::PERM ? ((R & ~31) + perm32(R & 31)) : R;
        voffA[i] = (unsigned)(R * lda + C) * 2u; voffB[i] = (unsigned)(Rb * ldb + C) * 2u; }
    const size_t kstep = (size_t)(BK * 2);
    const size_t hsA = (size_t)HALF * lda * 2, hsB = (size_t)HALF * ldb * 2;
    const size_t tsA = 2 * hsA, tsB = 2 * hsB;
    const unsigned ldsw = (unsigned)wid * 1024u;
    const int aoff = lds_byte(wr * 64 + fr, fq * 8), boff = lds_byte(wc * 32 + fr, fq * 8);
#define PG8_SA(b, h) (((b) * 2 + (h)) * HTB)
#define PG8_SB(b, h) ((4 + (b) * 2 + (h)) * HTB)
#define PG8_STAGE(bufoff, gbase, voff) do { _Pragma("unroll") for (int _i = 0; _i < 2; ++_i) \
        __builtin_amdgcn_global_load_lds((const unsigned*)((const char*)(gbase) + (voff)[_i]), (PG8_LAS unsigned*)(lds + (bufoff) + ldsw + _i * 8192), 16, 0, 0); } while (0)
#define PG8_LDA(dst, b, h) do { _Pragma("unroll") for (int m = 0; m < 4; ++m) _Pragma("unroll") for (int k = 0; k < 2; ++k) dst[m][k] = *(const PG8_LAS bf16x8*)(lds + PG8_SA(b, h) + aoff + m * 2048 + k * 1024); } while (0)
#define PG8_LDB(dst, b, h) do { _Pragma("unroll") for (int n = 0; n < 2; ++n) _Pragma("unroll") for (int k = 0; k < 2; ++k) dst[n][k] = *(const PG8_LAS bf16x8*)(lds + PG8_SB(b, h) + boff + n * 2048 + k * 1024); } while (0)
#define PG8_MMA(ai, bj, At, Bt) do { __builtin_amdgcn_s_setprio(1); _Pragma("unroll") for (int m = 0; m < 4; ++m) _Pragma("unroll") for (int n = 0; n < 2; ++n) _Pragma("unroll") for (int k = 0; k < 2; ++k) \
        acc[ai][bj][m][n] = __builtin_amdgcn_mfma_f32_16x16x32_bf16(Bt[n][k], At[m][k], acc[ai][bj][m][n], 0, 0, 0); __builtin_amdgcn_s_setprio(0); } while (0)
#define PG8_WAIT_V(n) asm volatile("s_waitcnt vmcnt(" #n ")" ::: "memory")
#define PG8_WAIT_L(n) asm volatile("s_waitcnt lgkmcnt(" #n ")" ::: "memory")
#define PG8_BAR __builtin_amdgcn_s_barrier()
#define PG8_SCHED __builtin_amdgcn_sched_barrier(0)
    Unit cur, nxt; int ui = 0;
    if (!S.next(0, cur)) return;
    f32x4 acc[2][2][4][2];
#pragma unroll
    for (int a = 0; a < 2; ++a)
#pragma unroll
        for (int b = 0; b < 2; ++b)
#pragma unroll
            for (int m = 0; m < 4; ++m)
#pragma unroll
                for (int n = 0; n < 2; ++n) acc[a][b][m][n] = (f32x4){0.f, 0.f, 0.f, 0.f};
    bf16x8 At[4][2], B0[2][2], B1[2][2];
    const char* cA = (const char*)g.A + (size_t)cur.pm * tsA; const char* cB = (const char*)g.Bt + (size_t)cur.pn * tsB;
    S.a_ready(cur);
    if constexpr (SP2) {
        PG8_STAGE(PG8_SB(0, 0), cB, voffB); PG8_STAGE(PG8_SB(0, 1), cB + hsB, voffB); PG8_STAGE(PG8_SA(0, 0), cA, voffA); PG8_STAGE(PG8_SA(0, 1), cA + hsA, voffA);
        if (wr == 1) PG8_BAR;
        PG8_WAIT_V(2); PG8_BAR;
        PG8_STAGE(PG8_SB(1, 0), cB + kstep, voffB); PG8_STAGE(PG8_SA(1, 0), cA + kstep, voffA); PG8_STAGE(PG8_SB(1, 1), cB + hsB + kstep, voffB);
        PG8_WAIT_V(6); PG8_BAR;
    } else {
        PG8_STAGE(PG8_SB(0, 0), cB, voffB); PG8_STAGE(PG8_SA(0, 0), cA, voffA); PG8_STAGE(PG8_SB(0, 1), cB + hsB, voffB); PG8_STAGE(PG8_SA(0, 1), cA + hsA, voffA);
        if (wr == 1) PG8_BAR;
        PG8_WAIT_V(4); PG8_BAR;
        PG8_STAGE(PG8_SB(1, 0), cB + kstep, voffB); PG8_STAGE(PG8_SA(1, 0), cA + kstep, voffA); PG8_STAGE(PG8_SB(1, 1), cB + hsB + kstep, voffB);
        PG8_WAIT_V(6); PG8_BAR;
    }
    for (;;) {
        const bool has_next = S.next(ui + 1, nxt);
        const char* nA = has_next ? (const char*)g.A + (size_t)nxt.pm * tsA : cA; const char* nB = has_next ? (const char*)g.Bt + (size_t)nxt.pn * tsB : cB;
        for (int t = 0; t < nt; t += 2) {
            const bool last = (t == nt - 2);
            const char* a1 = cA + (size_t)(t + 1) * kstep;
            const char* a2 = last ? nA : cA + (size_t)(t + 2) * kstep; const char* b2 = last ? nB : cB + (size_t)(t + 2) * kstep;
            const char* a3 = a2 + kstep; const char* b3 = b2 + kstep;
            if (last && has_next) S.a_ready(nxt);
            if constexpr (SP2) {
            PG8_LDB(B0, 0, 0); PG8_LDB(B1, 0, 1); PG8_SCHED; PG8_LDA(At, 0, 0); PG8_STAGE(PG8_SA(1, 1), a1 + hsA, voffA);
            PG8_WAIT_V(8); PG8_WAIT_L(0); PG8_BAR; PG8_MMA(0, 0, At, B0); PG8_MMA(0, 1, At, B1); PG8_BAR; PG8_SCHED;
            PG8_LDA(At, 0, 1); PG8_STAGE(PG8_SB(0, 0), b2, voffB); PG8_STAGE(PG8_SB(0, 1), b2 + hsB, voffB); PG8_STAGE(PG8_SA(0, 0), a2, voffA);
            PG8_WAIT_V(8); PG8_WAIT_L(0); PG8_BAR; PG8_MMA(1, 0, At, B0); PG8_MMA(1, 1, At, B1); PG8_BAR; PG8_SCHED;
            PG8_LDB(B0, 1, 0); PG8_LDB(B1, 1, 1); PG8_SCHED; PG8_LDA(At, 1, 0); PG8_STAGE(PG8_SA(0, 1), a2 + hsA, voffA);
            PG8_WAIT_V(8); PG8_WAIT_L(0); PG8_BAR; PG8_MMA(0, 0, At, B0); PG8_MMA(0, 1, At, B1); PG8_BAR; PG8_SCHED;
            PG8_LDA(At, 1, 1); PG8_STAGE(PG8_SB(1, 0), b3, voffB); PG8_STAGE(PG8_SB(1, 1), b3 + hsB, voffB); PG8_STAGE(PG8_SA(1, 0), a3, voffA);
            PG8_WAIT_V(8); PG8_WAIT_L(0); PG8_BAR; PG8_MMA(1, 0, At, B0); PG8_MMA(1, 1, At, B1); PG8_BAR; PG8_SCHED;
            } else {
            PG8_LDB(B0, 0, 0); PG8_SCHED; PG8_LDA(At, 0, 0); PG8_STAGE(PG8_SA(1, 1), a1 + hsA, voffA);
            PG8_WAIT_L(8); PG8_BAR; PG8_WAIT_L(0); PG8_MMA(0, 0, At, B0); PG8_BAR; PG8_SCHED;
            PG8_LDB(B1, 0, 1); PG8_STAGE(PG8_SB(0, 0), b2, voffB);
            PG8_BAR; PG8_WAIT_L(0); PG8_MMA(0, 1, At, B1); PG8_BAR;
            PG8_LDA(At, 0, 1); PG8_STAGE(PG8_SA(0, 0), a2, voffA);
            PG8_BAR; PG8_WAIT_L(0); PG8_MMA(1, 0, At, B0); PG8_BAR; PG8_SCHED;
            PG8_STAGE(PG8_SB(0, 1), b2 + hsB, voffB);
            PG8_WAIT_V(6); PG8_BAR; PG8_MMA(1, 1, At, B1); PG8_BAR;
            PG8_LDB(B0, 1, 0); PG8_SCHED; PG8_LDA(At, 1, 0); PG8_STAGE(PG8_SA(0, 1), a2 + hsA, voffA);
            PG8_WAIT_L(8); PG8_BAR; PG8_WAIT_L(0); PG8_MMA(0, 0, At, B0); PG8_BAR; PG8_SCHED;
            PG8_LDB(B1, 1, 1); PG8_STAGE(PG8_SB(1, 0), b3, voffB);
            PG8_BAR; PG8_WAIT_L(0); PG8_MMA(0, 1, At, B1); PG8_BAR;
            PG8_LDA(At, 1, 1); PG8_STAGE(PG8_SA(1, 0), a3, voffA);
            PG8_BAR; PG8_WAIT_L(0); PG8_MMA(1, 0, At, B0); PG8_BAR; PG8_SCHED;
            PG8_STAGE(PG8_SB(1, 1), b3 + hsB, voffB);
            PG8_WAIT_V(6); PG8_BAR; PG8_MMA(1, 1, At, B1); PG8_BAR;
            }
        }
        if constexpr (ALIGN_EPI) { if (wr == 0) PG8_BAR; }
        if constexpr (!Epi::AFTER_DRAIN) { const int l_ = lane_now(); E(acc, cur, wr, wc, l_ & 15, l_ >> 4); S.done(cur); }
        if (!has_next) break;
#pragma unroll
        for (int a = 0; a < 2; ++a)
#pragma unroll
            for (int b = 0; b < 2; ++b)
#pragma unroll
                for (int m = 0; m < 4; ++m)
#pragma unroll
                    for (int n = 0; n < 2; ++n) acc[a][b][m][n] = (f32x4){0.f, 0.f, 0.f, 0.f};
        cur = nxt; cA = nA; cB = nB; ++ui;
        if constexpr (ALIGN_EPI) { if (wr == 1) PG8_BAR; }
    }
    PG8_WAIT_V(0);
    if constexpr (!ALIGN_EPI) { if (wr == 0) PG8_BAR; }
    PG8_BAR;
    if constexpr (Epi::AFTER_DRAIN) { E.fused(acc, cur, wr, wc, fr, fq, lds, wid, lane); S.done(cur); }
#undef PG8_SA
#undef PG8_SB
#undef PG8_STAGE
#undef PG8_LDA
#undef PG8_LDB
#undef PG8_MMA
#undef PG8_WAIT_V
#undef PG8_WAIT_L
#undef PG8_BAR
#undef PG8_SCHED
}
}

namespace attn {
constexpr int DQK = 192, DV = 128, NW = 8, QBLK = 32, KVBLK = 64;
constexpr int LDQ = MH * MQD, LDK = MH * MQD, LDV = 1024, LDO = 1024;
constexpr float SCALE = 0.07216878364870322f;
constexpr float THR = 8.f;
constexpr int SHM_V = KVBLK * DV * 2, SHM_K = KVBLK * 400, SHM_ATTN = 2 * SHM_V + 2 * SHM_K + NW * 64 * 4;
constexpr int KROW = 400;
#define KSWZ(row, colB) ((row) * KROW + (colB))
#define SBAR() __builtin_amdgcn_sched_barrier(0)
__device__ __forceinline__ int crow(int r, int hi) { return (r & 3) + 8 * (r >> 2) + 4 * hi; }

__device__ __forceinline__ void partialSM(f32x16& p0, f32x16& p1, float& m_reg, float& mn, float& alpha, const float C, const float thr) {
  float m0 = fmaxf(p0[0], p0[1]), m1 = fmaxf(p0[2], p0[3]), m2 = fmaxf(p0[4], p0[5]), m3 = fmaxf(p0[6], p0[7]);
#pragma unroll
  for (int r = 8; r < 16; r += 4) { m0 = fmaxf(m0, p0[r]); m1 = fmaxf(m1, p0[r + 1]); m2 = fmaxf(m2, p0[r + 2]); m3 = fmaxf(m3, p0[r + 3]); }
#pragma unroll
  for (int r = 0; r < 16; r += 4) { m0 = fmaxf(m0, p1[r]); m1 = fmaxf(m1, p1[r + 1]); m2 = fmaxf(m2, p1[r + 2]); m3 = fmaxf(m3, p1[r + 3]); }
  float pmax = fmaxf(fmaxf(m0, m1), fmaxf(m2, m3));
  { auto rr = __builtin_amdgcn_permlane32_swap(__float_as_uint(pmax), __float_as_uint(pmax), false, false);
    pmax = fmaxf(__uint_as_float(rr[0]), __uint_as_float(rr[1])); }
  if (__builtin_expect(__all(pmax - m_reg <= thr), 1)) { mn = m_reg; alpha = 1.f; }
  else { mn = fmaxf(m_reg, pmax); alpha = __builtin_amdgcn_exp2f((m_reg - mn) * C); m_reg = mn; }
  float mnC = -mn * C;
#pragma unroll
  for (int r = 0; r < 16; ++r) p0[r] = fmaf(p0[r], C, mnC);
#pragma unroll
  for (int r = 0; r < 16; ++r) p1[r] = fmaf(p1[r], C, mnC);
#pragma unroll
  for (int r = 0; r < 16; ++r) p0[r] = __builtin_amdgcn_exp2f(p0[r]);
}
__device__ __forceinline__ void finishSM(f32x16& p0, f32x16& p1, float alpha, float& l_reg, bf16x8& pa0, bf16x8& pa1, bf16x8& pa2, bf16x8& pa3) {
#pragma unroll
  for (int r = 0; r < 16; ++r) p1[r] = __builtin_amdgcn_exp2f(p1[r]);
  float s0 = p0[0], s1 = p0[1], s2 = p0[2], s3 = p0[3];
#pragma unroll
  for (int r = 4; r < 16; r += 4) { s0 += p0[r]; s1 += p0[r + 1]; s2 += p0[r + 2]; s3 += p0[r + 3]; }
#pragma unroll
  for (int r = 0; r < 16; r += 4) { s0 += p1[r]; s1 += p1[r + 1]; s2 += p1[r + 2]; s3 += p1[r + 3]; }
  float ps = (s0 + s1) + (s2 + s3);
  { auto rr = __builtin_amdgcn_permlane32_swap(__float_as_uint(ps), __float_as_uint(ps), false, false);
    ps = __uint_as_float(rr[0]) + __uint_as_float(rr[1]); }
  l_reg = l_reg * alpha + ps;
#define PK4(P, BASE, OUT) do { unsigned a0 = cvtpk(P[BASE + 0], P[BASE + 1]), a1 = cvtpk(P[BASE + 2], P[BASE + 3]);   \
    unsigned b0 = cvtpk(P[BASE + 4], P[BASE + 5]), b1 = cvtpk(P[BASE + 6], P[BASE + 7]);                              \
    auto r0 = __builtin_amdgcn_permlane32_swap(a0, b0, false, false); auto r1 = __builtin_amdgcn_permlane32_swap(a1, b1, false, false); \
    u32x4 w = {r0[0], r1[0], r0[1], r1[1]}; OUT = *reinterpret_cast<bf16x8*>(&w); } while (0)
  PK4(p0, 0, pa0); PK4(p0, 8, pa1); PK4(p1, 0, pa2); PK4(p1, 8, pa3);
#undef PK4
}
__device__ __forceinline__ void qkt(f32x16& p0, f32x16& p1, const char* Ks, const bf16x8* qr, int r32, int hi) {
  p0 = f32x16{}; p1 = f32x16{};
  const char* kb = Ks + r32 * KROW + hi * 16;
#pragma unroll
  for (int d0 = 0; d0 < 12; ++d0) {
    bf16x8 b0 = *reinterpret_cast<const bf16x8*>(kb + d0 * 32);
    bf16x8 b1 = *reinterpret_cast<const bf16x8*>(kb + 32 * KROW + d0 * 32);
    p0 = __builtin_amdgcn_mfma_f32_32x32x16_bf16(b0, qr[d0], p0, 0, 0, 0);
    p1 = __builtin_amdgcn_mfma_f32_32x32x16_bf16(b1, qr[d0], p1, 0, 0, 0); }
}
__device__ __forceinline__ int v_st(int k, int c) { const int kk = (k & ~0xC) | ((k & 4) << 1) | ((k & 8) >> 1); return ((kk >> 3) * 4 + (c >> 5)) * 512 + ((kk & 7) * 32 + (c & 31)) * 2; }
__device__ __forceinline__ int v_rd_base(int lane) { return ((lane & 3) << 3) | (((lane >> 2) & 3) << 6) | (((lane >> 4) & 1) << 5) | (((lane >> 5) & 1) << 8); }
constexpr int v_rd_off(int d0, int ks, int half) { return d0 * 512 + ks * 4096 + half * 2048; }
template <int OFF> __device__ __forceinline__ s16x4 tr_read(int vb) {
  s16x4 r; asm volatile("ds_read_b64_tr_b16 %0, %1 offset:%2" : "=&v"(r) : "v"(vb), "i"(OFF) : "memory"); return r;
}
#define PKLH(L, H) (bf16x8){L[0], L[1], L[2], L[3], H[0], H[1], H[2], H[3]}
template <int D0> __device__ __forceinline__ void pv_one(f32x16& od, int vb, bf16x8 pa0, bf16x8 pa1, bf16x8 pa2, bf16x8 pa3) {
  const s16x4 l0 = tr_read<v_rd_off(D0, 0, 0)>(vb), h0 = tr_read<v_rd_off(D0, 0, 1)>(vb), l1 = tr_read<v_rd_off(D0, 1, 0)>(vb), h1 = tr_read<v_rd_off(D0, 1, 1)>(vb);
  const s16x4 l2 = tr_read<v_rd_off(D0, 2, 0)>(vb), h2 = tr_read<v_rd_off(D0, 2, 1)>(vb), l3 = tr_read<v_rd_off(D0, 3, 0)>(vb), h3 = tr_read<v_rd_off(D0, 3, 1)>(vb);
  asm volatile("s_waitcnt lgkmcnt(6)" ::: "memory"); SBAR();
  od = __builtin_amdgcn_mfma_f32_32x32x16_bf16(pa0, PKLH(l0, h0), od, 0, 0, 0); SBAR();
  asm volatile("s_waitcnt lgkmcnt(4)" ::: "memory"); SBAR();
  od = __builtin_amdgcn_mfma_f32_32x32x16_bf16(pa1, PKLH(l1, h1), od, 0, 0, 0); SBAR();
  asm volatile("s_waitcnt lgkmcnt(2)" ::: "memory"); SBAR();
  od = __builtin_amdgcn_mfma_f32_32x32x16_bf16(pa2, PKLH(l2, h2), od, 0, 0, 0); SBAR();
  asm volatile("s_waitcnt lgkmcnt(0)" ::: "memory"); SBAR();
  od = __builtin_amdgcn_mfma_f32_32x32x16_bf16(pa3, PKLH(l3, h3), od, 0, 0, 0);
}
__device__ __forceinline__ void pv_d0(f32x16* o, int vb, bf16x8 pa0, bf16x8 pa1, bf16x8 pa2, bf16x8 pa3) {
  pv_one<0>(o[0], vb, pa0, pa1, pa2, pa3); pv_one<1>(o[1], vb, pa0, pa1, pa2, pa3); pv_one<2>(o[2], vb, pa0, pa1, pa2, pa3); pv_one<3>(o[3], vb, pa0, pa1, pa2, pa3);
}

__device__ __forceinline__ void attn_unit(const bf16_t* __restrict__ Qb, const bf16_t* __restrict__ Kh, const bf16_t* __restrict__ Vh, bf16_t* __restrict__ Ob, const float* __restrict__ stq, int seq, char* lds, int tid_in) {
  int tid_o = tid_in; asm volatile("" : "+v"(tid_o));
  const int tid = tid_o, wid = tid >> 6, lane = tid & 63, r32 = lane & 31, hi = lane >> 5;
  char* V_lds = lds; char* K_lds = lds + 2 * SHM_V;
  float* wsf = (float*)(lds + 2 * SHM_V + 2 * SHM_K) + wid * 64; float* li_l = wsf; float* al_l = wsf + 32;
  float m_reg = -1e30f, l_reg = 0; f32x16 o[4] = {}; bf16x8 qr[12];
  float Cl, thrl; { const f32x4 sp = *(const f32x4*)(stq + (size_t)(wid * QBLK + r32) * 4); const float rsq = 1.0f / sqrtf(((sp[0] + sp[1]) + (sp[2] + sp[3])) * (1.0f / 256.0f) + EPS);
    Cl = SCALE * 1.4426950408889634f * rsq; thrl = THR / (SCALE * rsq); }
  const bf16_t* Qw = Qb + (long)(wid * QBLK + r32) * LDQ + hi * 8;
#pragma unroll
  for (int d0 = 0; d0 < 12; ++d0) qr[d0] = *reinterpret_cast<const bf16x8*>(Qw + d0 * 16);
  const int sr = tid >> 4, sc = (tid & 15) * 8, vst0 = v_st(sr, sc), vst1 = v_st(32 + sr, sc);
  const int kr_r = tid >> 3, kr_c = 128 + (tid & 7) * 8;
  const int vb0 = (int)(uintptr_t)V_lds + v_rd_base(lane);
  bf16x8 vs0, vs1, ks0, ks1, kx0;
#define SLOAD(k0) do { const unsigned vo_ = (unsigned)((k0) + sr) * LDV + sc, ko_ = (unsigned)((k0) + sr) * LDK + sc; \
    vs0 = *(const bf16x8*)(Vh + vo_); vs1 = *(const bf16x8*)(Vh + vo_ + 32u * LDV); \
    ks0 = *(const bf16x8*)(Kh + ko_); ks1 = *(const bf16x8*)(Kh + ko_ + 32u * LDK); kx0 = *(const bf16x8*)(Kh + (unsigned)((k0) + kr_r) * LDK + kr_c); } while (0)
#define SWRITE(b) do { *(bf16x8*)(V_lds + (b) * SHM_V + vst0) = vs0; *(bf16x8*)(V_lds + (b) * SHM_V + vst1) = vs1; \
    *(bf16x8*)(K_lds + (b) * SHM_K + KSWZ(sr, sc * 2)) = ks0; *(bf16x8*)(K_lds + (b) * SHM_K + KSWZ(32 + sr, sc * 2)) = ks1; *(bf16x8*)(K_lds + (b) * SHM_K + KSWZ(kr_r, kr_c * 2)) = kx0; } while (0)
#define SWAIT() asm volatile("s_waitcnt vmcnt(0)" ::: "memory")
#define RESC(a) do { if (__any((a) < 1.f)) { if (hi == 0) al_l[r32] = (a); asm volatile("s_waitcnt lgkmcnt(0)" ::: "memory"); \
    _Pragma("unroll") for (int d = 0; d < 4; ++d) _Pragma("unroll") for (int r = 0; r < 16; ++r) o[d][r] *= al_l[crow(r, hi)]; } } while (0)
  f32x16 pA0, pA1, pB0, pB1; float mnA, mnB, alA, alB; bf16x8 pa0, pa1, pa2, pa3; const int NT = seq / KVBLK;
  SLOAD(0); SWAIT(); SWRITE(0); __syncthreads();
  qkt(pA0, pA1, K_lds, qr, r32, hi); partialSM(pA0, pA1, m_reg, mnA, alA, Cl, thrl);
  SLOAD(KVBLK);
  SWAIT(); SWRITE(1); __syncthreads();
  for (int j = 1; j + 1 < NT; j += 2) {
    SBAR(); qkt(pB0, pB1, K_lds + SHM_K, qr, r32, hi);
    finishSM(pA0, pA1, alA, l_reg, pa0, pa1, pa2, pa3); SBAR();
    SLOAD((j + 1) * KVBLK); SBAR();
    pv_d0(o, vb0, pa0, pa1, pa2, pa3); partialSM(pB0, pB1, m_reg, mnB, alB, Cl, thrl);
    __syncthreads(); SWAIT(); SWRITE(0);
    RESC(alB); __syncthreads();
    SBAR(); qkt(pA0, pA1, K_lds, qr, r32, hi);
    finishSM(pB0, pB1, alB, l_reg, pa0, pa1, pa2, pa3); SBAR();
    SLOAD((j + 2) * KVBLK); SBAR();
    pv_d0(o, vb0 + SHM_V, pa0, pa1, pa2, pa3); partialSM(pA0, pA1, m_reg, mnA, alA, Cl, thrl);
    __syncthreads(); SWAIT(); SWRITE(1);
    RESC(alA); __syncthreads();
  }
  SBAR(); qkt(pB0, pB1, K_lds + SHM_K, qr, r32, hi);
  finishSM(pA0, pA1, alA, l_reg, pa0, pa1, pa2, pa3); SBAR();
  pv_d0(o, vb0, pa0, pa1, pa2, pa3); partialSM(pB0, pB1, m_reg, mnB, alB, Cl, thrl);
  __syncthreads(); RESC(alB);
  finishSM(pB0, pB1, alB, l_reg, pa0, pa1, pa2, pa3); SBAR();
  pv_d0(o, vb0 + SHM_V, pa0, pa1, pa2, pa3);
  if (hi == 0) li_l[r32] = l_reg; asm volatile("s_waitcnt lgkmcnt(0)" ::: "memory");
  float rli[16];
#pragma unroll
  for (int r = 0; r < 16; ++r) rli[r] = __builtin_amdgcn_rcpf(li_l[crow(r, hi)]);
  bf16_t* Ow = Ob + (long)(wid * QBLK) * LDO;
#pragma unroll
  for (int r = 0; r < 16; ++r) { int orow = crow(r, hi);
#pragma unroll
    for (int d0 = 0; d0 < 4; ++d0) { const float v = o[d0][r] * rli[r]; Ow[(long)orow * LDO + d0 * 32 + r32] = (bf16_t)(cvtpk(v, v) & 0xffffu); } }
  __syncthreads();
#undef SLOAD
#undef SWRITE
#undef SWAIT
#undef RESC
}
}

namespace gla {
constexpr int RQK = 272, RKE = 144, RSC = 144;
constexpr int OFF_QD = 0, OFF_KI = 17408, OFF_KET = 34816, OFF_SC = 53248, OFF_V = 62464, OFF_DEC = 95232, OFF_AF = 95744, OFF_TOT = 99840, OFF_RQ = 101888, OFF_RK = 118272, OFF_WA = 134656, GLA_LDS = 142848;
#define A256(row, b) ((row) * RQK + (b))
#define A128(row, b) ((row) * RKE + (b))
__device__ __forceinline__ bf16_t f2bf1(float x) { return (bf16_t)(cvtpk_c(x, x) & 0xffffu); }

template <int dir>
__device__ __forceinline__ void gla_item(const bf16_t* __restrict__ PQ, const bf16_t* __restrict__ PK, const bf16_t* __restrict__ PV, const bf16_t* __restrict__ PM,
                                         const float* __restrict__ wa, const float* __restrict__ ba, bf16_t* __restrict__ GO, int b, int h, char* lds, int tid_in) {
  using attn::crow;
  int tid_o = tid_in; asm volatile("" : "+v"(tid_o));
  const int tid = tid_o, wid = tid >> 6, lane = tid & 63, r32 = lane & 31, hi = lane >> 5;
  const int d = tid & 127, jq = tid >> 7;
  { const int dd = tid >> 2, r4 = (tid & 3) * 4;
    const float w0 = wa[(r4 + 0) * GQK + h * GDK + dd], w1 = wa[(r4 + 1) * GQK + h * GDK + dd], w2 = wa[(r4 + 2) * GQK + h * GDK + dd], w3 = wa[(r4 + 3) * GQK + h * GDK + dd];
    *(u32x2*)(lds + OFF_WA + dd * 32 + r4 * 2) = (u32x2){cvtpk_c(w0, w1), cvtpk_c(w2, w3)}; }
  const float bar = ba[h * GDK + d];
  f32x16 S[4] = {};
  const int vb = (int)(uintptr_t)(lds + OFF_V) + (wid >> 2) * 16384 + (wid & 3) * 512 + attn::v_rd_base(lane);
  float* AF = (float*)(lds + OFF_AF); float* TOT = (float*)(lds + OFF_TOT); float* DEC = (float*)(lds + OFF_DEC);
  bf16x8 vreg[4], qv[2], kv[2]; unsigned afw;
#define GLA_LOAD(ROW0) do { \
    _Pragma("unroll") for (int i = 0; i < 4; ++i) { const int cid = tid + 512 * i, j = cid >> 5, ec = (cid & 31) * 8; vreg[i] = *(const bf16x8*)(PV + ((ROW0) + j) * GVW + h * GDV + ec); } \
    afw = *(const unsigned*)(PM + ((ROW0) + (tid >> 3)) * 32 + dir * 16 + (tid & 7) * 2); \
    _Pragma("unroll") for (int i = 0; i < 2; ++i) { const int cid = tid + 512 * i, j = cid >> 4, dc = (cid & 15) * 8; qv[i] = *(const bf16x8*)(PQ + ((ROW0) + j) * GQK + h * GDK + dc); kv[i] = *(const bf16x8*)(PK + ((ROW0) + j) * GQK + h * GDK + dc); } } while (0)
  { const long r00 = (long)b * SEQ + (dir ? (SEQ / GCH - 1) : 0) * GCH; GLA_LOAD(r00); }
  for (int step = 0; step < SEQ / GCH; ++step) {
    const int n = dir ? (SEQ / GCH - 1 - step) : step;
    const long row0 = (long)b * SEQ + n * GCH;
    *(unsigned*)(lds + OFF_AF + (tid >> 3) * 32 + (tid & 7) * 4) = afw;
#pragma unroll
    for (int i = 0; i < 4; ++i) { const int cid = tid + 512 * i, j = cid >> 5, ec = (cid & 31) * 8; *(bf16x8*)(lds + OFF_V + (ec >> 7) * 16384 + attn::v_st(j, ec & 127)) = vreg[i]; }
#pragma unroll
    for (int i = 0; i < 2; ++i) { const int cid = tid + 512 * i, j = cid >> 4, dc = (cid & 15) * 8; *(bf16x8*)(lds + OFF_RQ + j * 256 + dc * 2) = qv[i]; *(bf16x8*)(lds + OFF_RK + j * 256 + dc * 2) = kv[i]; }
    __syncthreads();
    { const int jt = wid >> 2, dt = wid & 3;
      const bf16x8 af_ = *(const bf16x8*)(lds + OFF_AF + (32 * jt + r32) * 32 + hi * 16), wb_ = *(const bf16x8*)(lds + OFF_WA + (32 * dt + r32) * 32 + hi * 16);
      f32x16 zt = {}; zt = __builtin_amdgcn_mfma_f32_32x32x16_bf16(af_, wb_, zt, 0, 0, 0);
      float* ZL = (float*)(lds + OFF_QD);
#pragma unroll
      for (int r = 0; r < 16; ++r) ZL[(32 * jt + crow(r, hi)) * 128 + 32 * dt + r32] = zt[r]; }
    __syncthreads();
    float la[16];
#pragma unroll
    for (int jj = 0; jj < 16; ++jj) { const float z = ((const float*)(lds + OFF_QD))[(16 * jq + jj) * 128 + d] + bar;
      la[jj] = (fminf(z, 0.f) - __builtin_amdgcn_logf(1.f + __expf(-fabsf(z))) * 0.6931471805599453f) * 0.0625f; }
    if (!dir) { float s = 0.f;
#pragma unroll
      for (int jj = 0; jj < 16; ++jj) { s += la[jj]; la[jj] = s; } }
    else { float s = 0.f;
#pragma unroll
      for (int jj = 15; jj >= 0; --jj) { s += la[jj]; la[jj] = s; } }
    TOT[jq * 128 + d] = dir ? la[0] : la[15];
    __syncthreads();
    const float t0 = TOT[d], t1 = TOT[128 + d], t2 = TOT[256 + d], t3 = TOT[384 + d];
    const float bend = (t0 + t1) + (t2 + t3);
    float off;
    if (!dir) off = (jq == 0) ? 0.f : (jq == 1) ? t0 : (jq == 2) ? (t0 + t1) : (t0 + t1 + t2);
    else      off = (jq == 3) ? 0.f : (jq == 2) ? t3 : (jq == 1) ? (t3 + t2) : (t3 + t2 + t1);
    const float ebend = __expf(bend);
    unsigned kew[8];
#pragma unroll
    for (int jp = 0; jp < 8; ++jp) { float ke2[2];
#pragma unroll
      for (int e2 = 0; e2 < 2; ++e2) { const int jj = 2 * jp + e2, j = 16 * jq + jj; const float bb = off + la[jj];
        const float qf = bf2f(*(const bf16_t*)(lds + OFF_RQ + j * 256 + 2 * d)) * 0.08838834764831845f * __expf(bb), kf = bf2f(*(const bf16_t*)(lds + OFF_RK + j * 256 + 2 * d));
        *(bf16_t*)(lds + OFF_QD + A256(j, 2 * d)) = f2bf1(qf);
        const float kiv = kf * __expf(-bb);
        *(bf16_t*)(lds + OFF_KI + A256(j, 2 * d)) = f2bf1(kiv);
        ke2[e2] = kiv * ebend; }
      kew[jp] = cvtpk_c(ke2[0], ke2[1]); }
    *(u32x4*)(lds + OFF_KET + A128(d, 32 * jq)) = (u32x4){kew[0], kew[1], kew[2], kew[3]};
    *(u32x4*)(lds + OFF_KET + A128(d, 32 * jq + 16)) = (u32x4){kew[4], kew[5], kew[6], kew[7]};
    if (jq == 0) DEC[d] = ebend;
    __syncthreads();
    if (step + 1 < SEQ / GCH) { const long rown = row0 + (dir ? -GCH : GCH); GLA_LOAD(rown); }
    if (wid < 4) {
      const int jt = wid >> 1, it = wid & 1;
      const bool dead = dir ? (jt == 0 && it == 1) : (jt == 1 && it == 0);
      f32x16 acc = {};
      if (!dead) {
#pragma unroll
        for (int ks = 0; ks < 8; ++ks) { const int cb = (16 * ks + 8 * hi) * 2;
          const bf16x8 a = *(const bf16x8*)(lds + OFF_KI + A256(32 * jt + r32, cb));
          const bf16x8 bq = *(const bf16x8*)(lds + OFF_QD + A256(32 * it + r32, cb));
          acc = __builtin_amdgcn_mfma_f32_32x32x16_bf16(a, bq, acc, 0, 0, 0); }
      }
      const int ig = 32 * it + r32;
#pragma unroll
      for (int g = 0; g < 4; ++g) { float v[4];
#pragma unroll
        for (int e = 0; e < 4; ++e) { const int jg = 32 * jt + 8 * g + 4 * hi + e; const bool keep = dir ? (jg >= ig) : (jg <= ig); v[e] = keep ? acc[4 * g + e] : 0.f; }
        u32x2 w; w.x = cvtpk_c(v[0], v[1]); w.y = cvtpk_c(v[2], v[3]);
        *(u32x2*)(lds + OFF_SC + A128(ig, (32 * jt + 8 * g + 4 * hi) * 2)) = w; }
    }
    __syncthreads();
    bf16x8 vf[4];
    { const s16x4 l0 = attn::tr_read<attn::v_rd_off(0, 0, 0)>(vb), h0 = attn::tr_read<attn::v_rd_off(0, 0, 1)>(vb), l1 = attn::tr_read<attn::v_rd_off(0, 1, 0)>(vb), h1 = attn::tr_read<attn::v_rd_off(0, 1, 1)>(vb);
      const s16x4 l2 = attn::tr_read<attn::v_rd_off(0, 2, 0)>(vb), h2 = attn::tr_read<attn::v_rd_off(0, 2, 1)>(vb), l3 = attn::tr_read<attn::v_rd_off(0, 3, 0)>(vb), h3 = attn::tr_read<attn::v_rd_off(0, 3, 1)>(vb);
      asm volatile("s_waitcnt lgkmcnt(0)" ::: "memory"); __builtin_amdgcn_sched_barrier(0);
      vf[0] = PKLH(l0, h0); vf[1] = PKLH(l1, h1); vf[2] = PKLH(l2, h2); vf[3] = PKLH(l3, h3); }
    f32x16 oa[2] = {};
#pragma unroll
    for (int dt = 0; dt < 4; ++dt)
#pragma unroll
      for (int s = 0; s < 2; ++s) {
        u32x4 sw; sw.x = cvtpk_c(S[dt][8 * s + 0], S[dt][8 * s + 1]); sw.y = cvtpk_c(S[dt][8 * s + 2], S[dt][8 * s + 3]); sw.z = cvtpk_c(S[dt][8 * s + 4], S[dt][8 * s + 5]); sw.w = cvtpk_c(S[dt][8 * s + 6], S[dt][8 * s + 7]);
        const bf16x8 sb = *reinterpret_cast<bf16x8*>(&sw);
        const int bd = 32 * dt + 16 * s;
#pragma unroll
        for (int it = 0; it < 2; ++it) { const int i = 32 * it + r32;
          const s16x4 lo = *(const s16x4*)(lds + OFF_QD + A256(i, 2 * (bd + 4 * hi))), hh = *(const s16x4*)(lds + OFF_QD + A256(i, 2 * (bd + 8 + 4 * hi)));
          oa[it] = __builtin_amdgcn_mfma_f32_32x32x16_bf16(PKLH(lo, hh), sb, oa[it], 0, 0, 0); }
      }
#pragma unroll
    for (int ks = 0; ks < 4; ++ks)
#pragma unroll
      for (int it = 0; it < 2; ++it) { const bf16x8 a = *(const bf16x8*)(lds + OFF_SC + A128(32 * it + r32, (16 * ks + 8 * hi) * 2));
        oa[it] = __builtin_amdgcn_mfma_f32_32x32x16_bf16(a, vf[ks], oa[it], 0, 0, 0); }
#pragma unroll
    for (int it = 0; it < 2; ++it)
#pragma unroll
      for (int r = 0; r < 16; ++r) { const int i = 32 * it + crow(r, hi); GO[(row0 + i) * GVW + h * GDV + 32 * wid + r32] = f2bf1(oa[it][r]); }
#pragma unroll
    for (int dt = 0; dt < 4; ++dt) {
#pragma unroll
      for (int r = 0; r < 16; ++r) S[dt][r] *= DEC[32 * dt + crow(r, hi)];
#pragma unroll
      for (int ks = 0; ks < 4; ++ks) { const bf16x8 a = *(const bf16x8*)(lds + OFF_KET + A128(32 * dt + r32, (16 * ks + 8 * hi) * 2));
        S[dt] = __builtin_amdgcn_mfma_f32_32x32x16_bf16(a, vf[ks], S[dt], 0, 0, 0); }
    }
    __syncthreads();
  }
}
#undef GLA_LOAD
}

constexpr int NWAVES = 8, NTHREADS = 512;
#ifndef REP_P2
#define REP_P2 1
#endif
#ifndef REP_P3
#define REP_P3 1
#endif
#ifndef REP_P4
#define REP_P4 1
#endif
#ifndef REP_P6
#define REP_P6 1
#endif
#ifndef REP_P7
#define REP_P7 1
#endif
#ifndef REP_P9
#define REP_P9 1
#endif
#ifndef REP_P10
#define REP_P10 1
#endif
#ifndef REP_SYNC
#define REP_SYNC 0
#endif
constexpr int LDS_BYTES = 147456;
constexpr int LDS_MISC = 143360;

enum { I_XP = 0, I_XS, I_NPRE, I_WIN, I_WAF, I_BAF, I_WAB, I_BAB, I_GNORM, I_WOGLA, I_NQ, I_WUQ, I_NKV, I_WUK, I_WUV, I_WOMLA, I_WOUT, I_NPOST, I_NFPRE, I_WGATE, I_WUP, I_WDOWN, I_NFPOST };

struct WConv { const float* W0; const float* W1; const float* scale; bf16_t* WT; int K, Nsrc, Ndst, mode; };
__device__ __forceinline__ void wsrc(const float* W0, const float* W1, int mode, int nd, const float*& W, int& col) {
    W = W0; col = nd;
    switch (mode) {
    case 0: break;
    case 1:
        if (nd < 3072) col = nd;
        else if (nd < 4096) col = 3680 + (nd - 3072);
        else if (nd < 5120) col = 4704 + (nd - 4096);
        else if (nd < 5376) col = 3104 + (nd - 5120);
        else if (nd < 5632) col = 3360 + (nd - 5376);
        else { const int j = nd - 5632; if (j < 16) col = 3072 + j; else if (j < 32) col = 3088 + (j - 16); else if (j < 96) { const int s = j - 32; col = 3616 + (s & 1) * 32 + (s >> 1); } else col = -1; }
        break;
    case 2: { const int hh = nd / MQD, w = nd % MQD; if (w >= MNOPE) { const int s = w - MNOPE; col = hh * MQD + MNOPE + (s & 1) * 32 + (s >> 1); } } break;
    case 3: if (nd >= 1024) { W = W1; col = nd - 1024; } break;
    case 4: if (nd & 1) W = W1; col = nd >> 1; break;
    }
}
__device__ __forceinline__ void wconv_item(const float* W0, const float* W1, const float* scale, bf16_t* WT, int K, int Nsrc, int Ndst, int mode, float* scr, int item, int lane) {
    const int nblk = Ndst / 32, kb = item / nblk, nb = item % nblk, k0 = 64 * kb, n0 = 32 * nb;
    const float* W; int col; wsrc(W0, W1, mode, n0 + (lane & 31), W, col);
    float wv[32];
    const int cs_ = col < 0 ? 0 : col;
#pragma unroll
    for (int i = 0; i < 32; ++i) wv[i] = W[(size_t)(k0 + 2 * i + (lane >> 5)) * Nsrc + cs_];
#pragma unroll
    for (int i = 0; i < 32; ++i) { const int kk = 2 * i + (lane >> 5); float v = col < 0 ? 0.f : wv[i]; if (scale) v *= scale[k0 + kk]; scr[kk * 33 + (lane & 31)] = v; }
    asm volatile("s_waitcnt lgkmcnt(0)" ::: "memory");
    const int cc = lane & 7;
#pragma unroll
    for (int j = 0; j < 4; ++j) { const int n = (lane >> 3) + 8 * j; const float* s = scr + (8 * cc) * 33 + n;
        u32x4 o; o.x = cvtpk(s[0 * 33], s[1 * 33]); o.y = cvtpk(s[2 * 33], s[3 * 33]); o.z = cvtpk(s[4 * 33], s[5 * 33]); o.w = cvtpk(s[6 * 33], s[7 * 33]);
        *(u32x4*)(WT + (size_t)(n0 + n) * K + k0 + 8 * cc) = o; }
    asm volatile("s_waitcnt lgkmcnt(0)" ::: "memory");
}

__device__ __forceinline__ void ld_row_f32(const float* p, int lane, f32x4 (&v)[4]) {
#pragma unroll
    for (int j = 0; j < 4; ++j) v[j] = *(const f32x4*)(p + 4 * lane + 256 * j);
}
__device__ __forceinline__ void ld_row_bf16(const bf16_t* p, int lane, f32x4 (&v)[4]) {
#pragma unroll
    for (int j = 0; j < 4; ++j) { const u32x2 w = *(const u32x2*)(p + 4 * lane + 256 * j); v[j] = (f32x4){bflo(w.x), bfhi(w.x), bflo(w.y), bfhi(w.y)}; }
}
__device__ __forceinline__ float sumsq4(const f32x4 (&v)[4]) { float s = 0.f;
#pragma unroll
    for (int j = 0; j < 4; ++j) s += (v[j][0] * v[j][0] + v[j][1] * v[j][1]) + (v[j][2] * v[j][2] + v[j][3] * v[j][3]);
    return s; }
__device__ __forceinline__ void st_row_bf16(bf16_t* p, int lane, const f32x4 (&v)[4]) {
#pragma unroll
    for (int j = 0; j < 4; ++j) { u32x2 w; w.x = cvtpk(v[j][0], v[j][1]); w.y = cvtpk(v[j][2], v[j][3]); *(u32x2*)(p + 4 * lane + 256 * j) = w; }
}


#define XB_TMO      128
#define XB_XCNT(j)  (256  + 64 * (j))
#define XB_XSUB(j)  (1280 + 64 * (j))
#define XB_XGEN(j)  (2304 + 64 * (j))
#define XB_TOP      3328
#define XB_TOPGEN   3392
#define XCD_BAR_WORDS 3456
#define XB_SPIN_CAP (1u << 23)

__device__ __forceinline__ unsigned xb_ld(unsigned* p)              { return __hip_atomic_load(p, __ATOMIC_RELAXED, __HIP_MEMORY_SCOPE_AGENT); }
__device__ __forceinline__ unsigned xb_add(unsigned* p, unsigned v) { return __hip_atomic_fetch_add(p, v, __ATOMIC_RELAXED, __HIP_MEMORY_SCOPE_AGENT); }
__device__ __forceinline__ unsigned xb_xcc_id() { return (unsigned)__builtin_amdgcn_s_getreg((3 << 11) | 20) & 0xFu; }
#define XB_SPIN(cond, bar) do { unsigned _sp = 0; while (cond) { __builtin_amdgcn_s_sleep(1); \
    if ((++_sp & 255u) == 0u) { if (xb_ld(&(bar)[XB_TMO])) break; if (_sp > XB_SPIN_CAP) { atomicAdd(&(bar)[XB_TMO], 1u); break; } } } } while (0)

struct XcdBarrier {
    unsigned* bar; unsigned x;
    volatile LAS unsigned* st;
};

__device__ __forceinline__ XcdBarrier xcd_barrier_post(unsigned* bar, volatile LAS unsigned* st) {
    XcdBarrier b; b.bar = bar; b.x = xb_xcc_id(); b.st = st;
    if (threadIdx.x == 0) (void)xb_add(&bar[XB_XCNT(b.x)], 1u);
    return b;
}
__device__ __forceinline__ void xcd_barrier_complete(unsigned* bar, unsigned x, unsigned& nloc, unsigned& nx) {
    const unsigned G = gridDim.x * gridDim.y * gridDim.z;
    unsigned sum, cnt, mine, sp = 0u;
    for (;;) {
        sum = 0u; cnt = 0u; mine = 0u;
#pragma unroll
        for (unsigned j = 0; j < 16; ++j) { const unsigned c = xb_ld(&bar[XB_XCNT(j)]); sum += c; cnt += (c > 0u) ? 1u : 0u; mine = (j == x) ? c : mine; }
        if (sum == G) break;
        __builtin_amdgcn_s_sleep(1);
        if ((++sp & 255u) == 0u) { if (xb_ld(&bar[XB_TMO])) break; if (sp > XB_SPIN_CAP) { atomicAdd(&bar[XB_TMO], 1u); break; } }
    }
    nloc = mine > 0u ? mine : 1u; nx = cnt > 0u ? cnt : 1u;
}

__device__ __forceinline__ void xcd_barrier(const XcdBarrier& b) {
    asm volatile("s_waitcnt vmcnt(0)" ::: "memory");
    __syncthreads();
    if (threadIdx.x == 0) {
        unsigned* bar = b.bar;
        __builtin_amdgcn_s_waitcnt(0);
        unsigned nloc = b.st[0], nx = b.st[1];
        if (nloc == 0u) { xcd_barrier_complete(bar, b.x, nloc, nx); b.st[0] = nloc; b.st[1] = nx; }
        const unsigned old = xb_add(&bar[XB_XSUB(b.x)], 1u);
        const unsigned gen = old / nloc;
        if (old + 1u == (gen + 1u) * nloc) {
            __builtin_amdgcn_fence(__ATOMIC_RELEASE, "agent");
            asm volatile("s_waitcnt vmcnt(0)" ::: "memory");
            const unsigned og = xb_add(&bar[XB_TOP], 1u);
            const unsigned tg = og / nx;
            if (og + 1u == (tg + 1u) * nx) xb_add(&bar[XB_TOPGEN], 1u);
            else XB_SPIN(xb_ld(&bar[XB_TOPGEN]) == tg, bar);
            __builtin_amdgcn_fence(__ATOMIC_ACQUIRE, "agent");
            xb_add(&bar[XB_XGEN(b.x)], 1u);
            asm volatile("s_waitcnt vmcnt(0)" ::: "memory");
        } else {
            XB_SPIN(xb_ld(&bar[XB_XGEN(b.x)]) == gen, bar);
            __builtin_amdgcn_fence(__ATOMIC_ACQUIRE, "agent");
            asm volatile("s_waitcnt vmcnt(0)" ::: "memory");
        }
    }
    __syncthreads();
}

#define GSYNC_CG() do { __builtin_amdgcn_fence(__ATOMIC_RELEASE, "agent"); asm volatile("s_waitcnt vmcnt(0) lgkmcnt(0)" ::: "memory"); grid.sync(); __builtin_amdgcn_fence(__ATOMIC_ACQUIRE, "agent"); asm volatile("s_waitcnt vmcnt(0)" ::: "memory"); } while (0)
#define GSYNC() xcd_barrier(xbar)
__device__ __forceinline__ int bid_now() { int b = (int)blockIdx.x; asm volatile("" : "+s"(b)); return b; }
#define TIDNOW() (wave_s * 64 + lane_now())
#define OPQ() int tid_q = TIDNOW(); asm volatile("" : "+v"(tid_q)); const int tid = tid_q, lane = tid & 63, wave = wave_s, gw = blockIdx.x * NWAVES + wave_s; (void)tid; (void)lane; (void)gw
__global__ void __launch_bounds__(NTHREADS, 2) fwd_megakernel(KArgs args) {
    extern __shared__ __attribute__((aligned(16))) unsigned char lds[];
    cg::grid_group grid = cg::this_grid();
    const int wave_s = __builtin_amdgcn_readfirstlane(threadIdx.x >> 6);
    const int tid = TIDNOW(), lane = tid & 63, wave = wave_s;
    const int G = gridDim.x, gw = blockIdx.x * NWAVES + wave, NGW = G * NWAVES;
    unsigned char* ws = args.ws;
#define in args.in
    unsigned* ctl = (unsigned*)(ws + WS_CTL);

    {
        if (blockIdx.x == 0) for (int w = tid; w < 8192; w += NTHREADS) ctl[w] = 0u;
        if (tid < 64) ((volatile LAS unsigned*)(lds + LDS_MISC))[tid] = 0u;
        float* rt = (float*)(ws + WS_ROPE);
        for (int e = blockIdx.x * NTHREADS + tid; e < SEQ * 32; e += G * NTHREADS) {
            const int pos = e >> 5, i = e & 31;
            double fq_ = 0.0;
#pragma unroll
            for (int k = 0; k < 32; ++k) fq_ = (k == i) ? args.inv_freq[k] : fq_;
            const double rev = (double)pos * fq_ * 0.15915494309189535;
            const float fr = (float)(rev - rint(rev));
            rt[2 * e] = __builtin_amdgcn_cosf(fr); rt[2 * e + 1] = __builtin_amdgcn_sinf(fr);
        }
        float* scr = (float*)(lds + wave * 16384);
#define WCONV(W0_, W1_, SC_, OFF_, K_, NS_, ND_, MODE_) do { \
            for (int it = gw; it < ((K_) / 64) * ((ND_) / 32); it += NGW) wconv_item(W0_, W1_, SC_, (bf16_t*)(ws + OFF_), K_, NS_, ND_, MODE_, scr, it, lane); } while (0)
#ifndef REP_P0
#define REP_P0 1
#endif
        for (int rp0_ = 0; rp0_ < REP_P0; ++rp0_) {
        WCONV(in[I_WIN], nullptr, nullptr, W_IN, DM, D_IN, NINP, 1);
        WCONV(in[I_WUQ], nullptr, in[I_NQ], W_UQ, MQR, MH * MQD, MH * MQD, 2);
        WCONV(in[I_WUK], in[I_WUV], in[I_NKV], W_UKV, MQR, 1024, 2048, 3);
        WCONV(in[I_WOGLA], nullptr, nullptr, W_OGLA, DM, DM, DM, 0);
        WCONV(in[I_WOMLA], nullptr, nullptr, W_OMLA, DM, DM, DM, 0);
        WCONV(in[I_WOUT], nullptr, nullptr, W_OUT, DM, DM, DM, 0);
        WCONV(in[I_WGATE], in[I_WUP], nullptr, W_GU, DM, DFF, 2 * DFF, 4);
        WCONV(in[I_WDOWN], nullptr, nullptr, W_DOWN, DFF, DM, DM, 0);
        }
#undef WCONV
    }

    XcdBarrier xbar; xbar.bar = ctl + 4096; xbar.x = 0u; xbar.st = (volatile LAS unsigned*)(lds + LDS_MISC) + 8;
    for (int grp = 0; grp < NGROUP; ++grp) {
        const size_t tok0 = (size_t)grp * GT;
        typedef __attribute__((address_space(1))) unsigned char gu8_t;
        gu8_t* wsq_ = (gu8_t*)args.ws; asm volatile("" : "+s"(wsq_));
        unsigned char* ws = (unsigned char*)wsq_;
#define WSQ() do { wsq_ = (gu8_t*)args.ws; asm volatile("" : "+s"(wsq_)); ws = (unsigned char*)wsq_; } while (0)
        const float* xg = (grp < 2) ? in[I_XP] + tok0 * DM : in[I_XS];
        float* outg = args.out + tok0 * DM;
        bf16_t* H = (bf16_t*)(ws + WS_H);
        WSQ();
        if (grp == 0) {
            OPQ();
            bf16_t* HX = (bf16_t*)(ws + WS_HX);
            f32x4 gv[4]; ld_row_f32(in[I_NPRE], lane, gv);
            { int m = gw; do { f32x4 v[4]; ld_row_f32(xg + (size_t)m * DM, lane, v);
                const float rs = 1.0f / sqrtf(wave_sum(sumsq4(v)) * (1.0f / DM) + EPS);
#pragma unroll
                for (int j = 0; j < 4; ++j) v[j] = v[j] * rs * gv[j];
                st_row_bf16(HX + (size_t)m * DM, lane, v);  m += NGW; } while (m < GT); }
            GSYNC_CG(); xbar = xcd_barrier_post(ctl + 4096, (volatile LAS unsigned*)(lds + LDS_MISC) + 8);
        }
#ifndef SKIP_MIXER
        for (int rs_ = 0; rs_ < REP_SYNC; ++rs_) GSYNC();
        WSQ();
        for (int rep_ = 0; rep_ < REP_P2; ++rep_) {
#ifndef SKIP_G0
        { pg8::Gemm g{(const bf16_t*)(ws + WS_HX), (const bf16_t*)(ws + W_IN), GT, NINP, DM, DM, DM}; pg8::StaticOrder S; S.init(GT, NINP, G, bid_now());
          pg8::EpiInProj E{ws}; pg8::gemm_phase<pg8::EpiInProj, pg8::StaticOrder, true, true>((LAS unsigned char*)lds, g, S, E, TIDNOW()); }
#endif
        GSYNC();
        }
        WSQ();
        for (int rep_ = 0; rep_ < REP_P3; ++rep_) {
#ifndef SKIP_G1
        { pg8::Gemm g{(const bf16_t*)(ws + P_CQ), (const bf16_t*)(ws + W_UQ), GT, MH * MQD, MQR, MQR, MQR}; pg8::StaticOrder S; S.init(GT, MH * MQD, G, bid_now());
          pg8::EpiMlaQ E{ws}; pg8::gemm_phase<pg8::EpiMlaQ, pg8::StaticOrder, true, true>((LAS unsigned char*)lds, g, S, E, TIDNOW()); }
#endif
#ifndef SKIP_G2
        { pg8::Gemm g{(const bf16_t*)(ws + P_CKV), (const bf16_t*)(ws + W_UKV), GT, 2048, MQR, MQR, MQR}; pg8::StaticOrder S; S.init(GT, 2048, G, bid_now());
          pg8::EpiMlaKV E{ws}; pg8::gemm_phase<pg8::EpiMlaKV, pg8::StaticOrder, true, true>((LAS unsigned char*)lds, g, S, E, TIDNOW()); }
#endif
        GSYNC();
        }
        WSQ();
        for (int rep_ = 0; rep_ < REP_P4; ++rep_) {
        {
            OPQ();
            volatile unsigned* slot = (volatile unsigned*)(lds + LDS_MISC);
#ifndef REP_GLA
#define REP_GLA 1
#endif
            constexpr int NGLA1 = GB * GH * 2, NGLA = NGLA1 * REP_GLA, NATT = GB * MH * (SEQ / 256);
            const int NP1 = (grp + 1 < NGROUP) ? GT / 64 : 0, NP11 = (grp > 0) ? GT / 64 : 0;
            for (;;) {
                if (tid == 0) *slot = atomicAdd(ctl + 64 * (grp + 3 * rep_), 1u);
                __syncthreads();
                const unsigned u = (unsigned)__builtin_amdgcn_readfirstlane((int)*slot);
                __syncthreads();
                if (u >= (unsigned)(NGLA + NATT + NP1 + NP11)) break;
                if (u < (unsigned)NGLA) {
                    const int ug = (int)(u % (unsigned)NGLA1), dir = ug & 1, h = (ug >> 1) & 3, b = ug >> 3;
#ifdef NO_GLA
                    { int t_ = TIDNOW(); asm volatile("" : "+v"(t_)); bf16_t* go = (bf16_t*)(ws + (dir ? WS_GOB : WS_GOF));
_Pragma("unroll 1") for (int e = t_; e < SEQ * GDV; e += NTHREADS) go[((size_t)b * SEQ + (e >> 8)) * GVW + h * GDV + (e & 255)] = 0; }
#else
                    if (dir) gla::gla_item<1>((const bf16_t*)(ws + P_Q), (const bf16_t*)(ws + P_K), (const bf16_t*)(ws + P_V), (const bf16_t*)(ws + WS_PMISC), in[I_WAB], in[I_BAB], (bf16_t*)(ws + WS_GOB), b, h, (char*)lds, TIDNOW());
                    else     gla::gla_item<0>((const bf16_t*)(ws + P_Q), (const bf16_t*)(ws + P_K), (const bf16_t*)(ws + P_V), (const bf16_t*)(ws + WS_PMISC), in[I_WAF], in[I_BAF], (bf16_t*)(ws + WS_GOF), b, h, (char*)lds, TIDNOW());
#endif
                } else if (u >= (unsigned)(NGLA + NATT + NP1)) {
                    const int p11 = (int)u - NGLA - NATT - NP1, l1 = lane_now();
                    float* outp = args.out + (size_t)(grp - 1) * GT * DM;
                    const bf16_t* F = (const bf16_t*)(ws + WS_F);
                    f32x4 gq[4]; ld_row_f32(in[I_NFPOST], l1, gq);
_Pragma("unroll 1") for (int k = 0; k < 8; ++k) { const int m = p11 * 64 + wave_s * 8 + k; f32x4 fv[4], xv[4]; ld_row_bf16(F + (size_t)m * DM, l1, fv); ld_row_f32(outp + (size_t)m * DM, l1, xv);
                        const float rs = 1.0f / sqrtf(wave_sum(sumsq4(fv)) * (1.0f / DM) + EPS);
_Pragma("unroll") for (int j = 0; j < 4; ++j) *(f32x4*)(outp + (size_t)m * DM + 4 * l1 + 256 * j) = xv[j] + fv[j] * rs * gq[j]; }
                } else if (u >= (unsigned)(NGLA + NATT)) {
                    const int p1 = (int)u - NGLA - NATT, l1 = lane_now();
                    const float* xn = (grp + 1 < 2) ? in[I_XP] + (size_t)(grp + 1) * GT * DM : in[I_XS];
                    bf16_t* HX = (bf16_t*)(ws + WS_HX);
                    f32x4 gv[4]; ld_row_f32(in[I_NPRE], l1, gv);
_Pragma("unroll 1") for (int k = 0; k < 8; ++k) { const int m = p1 * 64 + wave_s * 8 + k; f32x4 v[4]; ld_row_f32(xn + (size_t)m * DM, l1, v);
                        const float rs = 1.0f / sqrtf(wave_sum(sumsq4(v)) * (1.0f / DM) + EPS);
_Pragma("unroll") for (int j = 0; j < 4; ++j) v[j] = v[j] * rs * gv[j];
                        st_row_bf16(HX + (size_t)m * DM, l1, v); }
                } else {
                    const int a = u - NGLA, qb = a & 7, h = (a >> 3) & 7, b = a >> 6;
                    const size_t r0 = (size_t)b * SEQ;
#ifdef NO_ATTN
                    { int t_ = TIDNOW(); asm volatile("" : "+v"(t_)); bf16_t* mo = (bf16_t*)(ws + WS_MO) + (r0 + qb * 256) * 1024 + h * MV_;
_Pragma("unroll 1") for (int e = t_; e < 256 * 128; e += NTHREADS) mo[(size_t)(e >> 7) * 1024 + (e & 127)] = 0; }
#else
                    attn::attn_unit((const bf16_t*)(ws + WS_MQ) + (r0 + qb * 256) * (MH * MQD) + h * MQD, (const bf16_t*)(ws + WS_MK) + r0 * (MH * MQD) + h * MQD,
                                    (const bf16_t*)(ws + WS_MV) + r0 * 1024 + h * MV_, (bf16_t*)(ws + WS_MO) + (r0 + qb * 256) * 1024 + h * MV_, (const float*)(ws + WS_STAT) + (r0 + qb * 256) * 4, SEQ, (char*)lds, TIDNOW());
#endif
                }
            }
        }
        GSYNC();
        }
        WSQ();
        {
            OPQ();
            bf16_t* gof = (bf16_t*)(ws + WS_GOF); const bf16_t* gob = (const bf16_t*)(ws + WS_GOB); const bf16_t* pg = (const bf16_t*)(ws + P_G);
            float gn[16];
#pragma unroll
            for (int e = 0; e < 16; ++e) gn[e] = in[I_GNORM][(16 * lane + e) & 255];
            { int m = gw; do {
                u32x4 a0[2], a1[2], b0[2], b1[2], g0[2], g1[2];
#pragma unroll
                for (int t = 0; t < 2; ++t) { const size_t off = (size_t)(m + t * NGW) * 1024 + 16 * lane;
                    a0[t] = *(const u32x4*)(gof + off); a1[t] = *(const u32x4*)(gof + off + 8); b0[t] = *(const u32x4*)(gob + off); b1[t] = *(const u32x4*)(gob + off + 8);
                    g0[t] = *(const u32x4*)(pg + off); g1[t] = *(const u32x4*)(pg + off + 8); }
#pragma unroll
                for (int t = 0; t < 2; ++t) { const size_t off = (size_t)(m + t * NGW) * 1024 + 16 * lane;
                    float o[16], gg[16];
#pragma unroll
                    for (int q = 0; q < 4; ++q) { o[2 * q] = bflo(a0[t][q]) + bflo(b0[t][q]); o[2 * q + 1] = bfhi(a0[t][q]) + bfhi(b0[t][q]); o[8 + 2 * q] = bflo(a1[t][q]) + bflo(b1[t][q]); o[8 + 2 * q + 1] = bfhi(a1[t][q]) + bfhi(b1[t][q]);
                        gg[2 * q] = bflo(g0[t][q]); gg[2 * q + 1] = bfhi(g0[t][q]); gg[8 + 2 * q] = bflo(g1[t][q]); gg[8 + 2 * q + 1] = bfhi(g1[t][q]); }
                    float s = 0.f;
#pragma unroll
                    for (int e = 0; e < 16; ++e) s += o[e] * o[e];
                    s = red16(s);
                    const float rs = 1.0f / sqrtf(s * (1.0f / GDV) + EPS);
#pragma unroll
                    for (int e = 0; e < 16; ++e) o[e] = o[e] * rs * gn[e] * (gg[e] * fsigmoid(gg[e]));
                    u32x4 w0, w1;
#pragma unroll
                    for (int q = 0; q < 4; ++q) { w0[q] = cvtpk(o[2 * q], o[2 * q + 1]); w1[q] = cvtpk(o[8 + 2 * q], o[8 + 2 * q + 1]); }
                    *(u32x4*)(gof + off) = w0; *(u32x4*)(gof + off + 8) = w1; }
                m += 2 * NGW; } while (m < GT); }
        }
        GSYNC();
        WSQ();
        for (int rep_ = 0; rep_ < REP_P6; ++rep_) {
#ifndef SKIP_G3
        { pg8::Gemm g{(const bf16_t*)(ws + WS_GOF), (const bf16_t*)(ws + W_OGLA), GT, DM, DM, DM, DM}; pg8::StaticOrder S; S.init(GT, DM, G, bid_now());
          pg8::EpiGate<0> E{(const bf16_t*)(ws + P_GA), (bf16_t*)(ws + WS_MERGED)}; pg8::gemm_phase<pg8::EpiGate<0>, pg8::StaticOrder, true, true>((LAS unsigned char*)lds, g, S, E, TIDNOW()); }
#endif
#ifndef SKIP_G4
        { pg8::Gemm g{(const bf16_t*)(ws + WS_MO), (const bf16_t*)(ws + W_OMLA), GT, DM, DM, DM, DM}; pg8::StaticOrder S; S.init(GT, DM, G, bid_now());
          pg8::EpiGate<1> E{(const bf16_t*)(ws + P_GB), (bf16_t*)(ws + WS_MERGED)}; pg8::gemm_phase<pg8::EpiGate<1>, pg8::StaticOrder, true, true>((LAS unsigned char*)lds, g, S, E, TIDNOW()); }
#endif
        GSYNC();
        }
        WSQ();
        for (int rep_ = 0; rep_ < REP_P7; ++rep_) {
#ifndef SKIP_G5
        { pg8::Gemm g{(const bf16_t*)(ws + WS_MERGED), (const bf16_t*)(ws + W_OUT), GT, DM, DM, DM, DM}; pg8::StaticOrder S; S.init(GT, DM, G, bid_now());
          pg8::EpiBf16Plain E{(bf16_t*)(ws + WS_U), DM}; pg8::gemm_phase<pg8::EpiBf16Plain, pg8::StaticOrder, true, true>((LAS unsigned char*)lds, g, S, E, TIDNOW()); }
#endif
        GSYNC();
        }
#endif
        WSQ();
        {
            OPQ();
            f32x4 gp[4], gf[4]; ld_row_f32(in[I_NPOST], lane, gp); ld_row_f32(in[I_NFPRE], lane, gf);
            const bf16_t* U = (const bf16_t*)(ws + WS_U);
            { int m = gw; do { f32x4 uv[4][4], xv[4][4];
#pragma unroll
                for (int t = 0; t < 4; ++t) { ld_row_bf16(U + (size_t)(m + t * NGW) * DM, lane, uv[t]); ld_row_f32(xg + (size_t)(m + t * NGW) * DM, lane, xv[t]); }
#pragma unroll
                for (int t = 0; t < 4; ++t) { const size_t mm = (size_t)(m + t * NGW);
#ifdef SKIP_MIXER
                    for (int j = 0; j < 4; ++j) uv[t][j] = (f32x4){0.f, 0.f, 0.f, 0.f};
#endif
                    const float rs = 1.0f / sqrtf(wave_sum(sumsq4(uv[t])) * (1.0f / DM) + EPS);
#pragma unroll
                    for (int j = 0; j < 4; ++j) xv[t][j] = xv[t][j] + uv[t][j] * rs * gp[j];
#pragma unroll
                    for (int j = 0; j < 4; ++j) *(f32x4*)(outg + mm * DM + 4 * lane + 256 * j) = xv[t][j];
                    const float rs2 = 1.0f / sqrtf(wave_sum(sumsq4(xv[t])) * (1.0f / DM) + EPS);
#pragma unroll
                    for (int j = 0; j < 4; ++j) xv[t][j] = xv[t][j] * rs2 * gf[j];
                    st_row_bf16(H + mm * DM, lane, xv[t]); }
                m += 4 * NGW; } while (m < GT); }
        }
        GSYNC();
        WSQ();
        for (int rep_ = 0; rep_ < REP_P9; ++rep_) {
#ifndef SKIP_G6
        { pg8::Gemm g{H, (const bf16_t*)(ws + W_GU), GT, 2 * DFF, DM, DM, DM}; pg8::StaticOrder S; S.init(GT, 2 * DFF, G, bid_now());
          pg8::EpiSwiGLU E{(bf16_t*)(ws + WS_A)}; pg8::gemm_phase<pg8::EpiSwiGLU, pg8::StaticOrder, true, true>((LAS unsigned char*)lds, g, S, E, TIDNOW()); }
#endif
        GSYNC();
        }
        WSQ();
        for (int rep_ = 0; rep_ < REP_P10; ++rep_) {
#ifndef SKIP_G7
        { pg8::Gemm g{(const bf16_t*)(ws + WS_A), (const bf16_t*)(ws + W_DOWN), GT, DM, DFF, DFF, DFF}; pg8::StaticOrder S; S.init(GT, DM, G, bid_now());
          pg8::EpiBf16Plain E{(bf16_t*)(ws + WS_F), DM}; pg8::gemm_phase<pg8::EpiBf16Plain, pg8::StaticOrder, true, true>((LAS unsigned char*)lds, g, S, E, TIDNOW()); }
#endif
        GSYNC();
        }
        WSQ();
        if (grp == NGROUP - 1) {
            OPQ();
            f32x4 gq[4]; ld_row_f32(in[I_NFPOST], lane, gq);
            const bf16_t* F = (const bf16_t*)(ws + WS_F);
            { int m = gw; do { f32x4 fv[4], xv[4]; ld_row_bf16(F + (size_t)m * DM, lane, fv); ld_row_f32(outg + (size_t)m * DM, lane, xv);
                const float rs = 1.0f / sqrtf(wave_sum(sumsq4(fv)) * (1.0f / DM) + EPS);
#pragma unroll
                for (int j = 0; j < 4; ++j) *(f32x4*)(outg + (size_t)m * DM + 4 * lane + 256 * j) = xv[j] + fv[j] * rs * gq[j];  m += NGW; } while (m < GT); }
        }
    }
}

#undef in
extern "C" void kernel_launch(void* const* d_in, const int* in_sizes, int n_in, void* d_out, int out_size, void* d_ws, size_t ws_size, hipStream_t stream) {
    static int grid = 0;
    if (grid == 0) {
        if (n_in != 23 || out_size != TTOT * DM || ws_size < WS_END) { fprintf(stderr, "kernel_launch: unexpected shapes n_in %d out %d ws %zu\n", n_in, out_size, ws_size); grid = -1; return; }
        int dev = 0, cus = 0, per_cu = 0;
        hipGetDevice(&dev); hipDeviceGetAttribute(&cus, hipDeviceAttributeMultiprocessorCount, dev);
        if (hipFuncSetAttribute((const void*)fwd_megakernel, hipFuncAttributeMaxDynamicSharedMemorySize, LDS_BYTES) != hipSuccess) { fprintf(stderr, "kernel_launch: hipFuncSetAttribute failed\n"); grid = -1; return; }
        if (hipOccupancyMaxActiveBlocksPerMultiprocessor(&per_cu, (const void*)fwd_megakernel, NTHREADS, LDS_BYTES) != hipSuccess || per_cu < 1) { fprintf(stderr, "kernel_launch: occupancy query %d\n", per_cu); per_cu = 1; }
        (void)hipGetLastError();
        grid = cus * 1;
    }
    if (grid < 0) return;
    KArgs a{};
    for (int i = 0; i < 23; ++i) a.in[i] = (const float*)d_in[i];
    a.out = (float*)d_out; a.ws = (unsigned char*)d_ws;
    for (int i = 0; i < 32; ++i) a.inv_freq[i] = pow(10000.0, -(double)(2 * i) / 64.0);
    void* kargs[] = {&a};
    hipError_t e = hipLaunchCooperativeKernel((const void*)fwd_megakernel, dim3(grid), dim3(NTHREADS), kargs, LDS_BYTES, stream);
    if (e != hipSuccess) fprintf(stderr, "kernel_launch: cooperative launch failed: %s (grid %d)\n", hipGetErrorString(e), grid);
}
```

```cpp
#include <hip/hip_runtime.h>
#include <hip/hip_cooperative_groups.h>
#include <cstdio>
#include <cstdint>
#include <cmath>
namespace cg = cooperative_groups;

constexpr int DM = 1024, SEQ = 2048, NB_TOTAL = 48, TTOT = NB_TOTAL * SEQ;
constexpr int GB = 16, GT = GB * SEQ, NGROUP = NB_TOTAL / GB;
constexpr int D_IN = 5728, NINP = 5888;
constexpr int GQK = 512, GVW = 1024, GH = 4, GDK = 128, GDV = 256, GRANK = 16, GCH = 64;
constexpr int MH = 8, MQR = 256, MNOPE = 128, MROPE = 64, MQD = 192, MV_ = 128;
constexpr int DFF = 2816;
constexpr float EPS = 1e-6f;
constexpr size_t MiB = 1u << 20;
constexpr size_t WS_CTL = 0;
constexpr size_t WS_ROPE = 256 * 1024;
constexpr size_t WS_W = 1 * MiB;
constexpr size_t W_IN = WS_W;
constexpr size_t W_UQ = W_IN + (size_t)NINP * DM * 2;
constexpr size_t W_UKV = W_UQ + (size_t)1536 * 256 * 2;
constexpr size_t W_OGLA = W_UKV + (size_t)2048 * 256 * 2;
constexpr size_t W_OMLA = W_OGLA + (size_t)DM * DM * 2;
constexpr size_t W_OUT = W_OMLA + (size_t)DM * DM * 2;
constexpr size_t W_GU = W_OUT + (size_t)DM * DM * 2;
constexpr size_t W_DOWN = W_GU + (size_t)2 * DFF * DM * 2;
constexpr size_t W_END = W_DOWN + (size_t)DM * DFF * 2;
static_assert(W_END <= 44 * MiB, "weights region");
constexpr size_t WS_STAT = 44 * MiB;
constexpr size_t WS_PMISC = 46 * MiB;
constexpr size_t WS_H = 48 * MiB;
constexpr size_t WS_P = 112 * MiB;
constexpr size_t P_Q = WS_P, P_K = WS_P + 32 * MiB, P_V = WS_P + 64 * MiB, P_G = WS_P + 128 * MiB, P_GA = WS_P + 192 * MiB, P_GB = WS_P + 256 * MiB;
constexpr size_t P_CQ = WS_P + 320 * MiB, P_CKV = WS_P + 336 * MiB;
constexpr size_t WS_MQ = 464 * MiB;
constexpr size_t WS_MK = 560 * MiB;
constexpr size_t WS_MV = 656 * MiB;
constexpr size_t WS_MO = 720 * MiB;
constexpr size_t WS_GOF = 784 * MiB;
constexpr size_t WS_GOB = 848 * MiB;
constexpr size_t WS_HX = 912 * MiB;
constexpr size_t WS_END = 976 * MiB;
constexpr size_t WS_MERGED = P_V;
constexpr size_t WS_U = WS_MQ;
constexpr size_t WS_A = WS_P;
constexpr size_t WS_F = WS_H;

#define LAS __attribute__((address_space(3)))
typedef unsigned short bf16_t;
typedef short bf16x8 __attribute__((ext_vector_type(8)));
typedef short s16x4 __attribute__((ext_vector_type(4)));
typedef float f32x4 __attribute__((ext_vector_type(4)));
typedef float f32x2 __attribute__((ext_vector_type(2)));
typedef float f32x16 __attribute__((ext_vector_type(16)));
typedef unsigned u32x4 __attribute__((ext_vector_type(4)));
typedef unsigned u32x2 __attribute__((ext_vector_type(2)));

__device__ __forceinline__ float bf2f(unsigned b) { return __uint_as_float(b << 16); }
__device__ __forceinline__ float bflo(unsigned w) { return __uint_as_float(w << 16); }
__device__ __forceinline__ float bfhi(unsigned w) { return __uint_as_float(w & 0xffff0000u); }
__device__ __forceinline__ unsigned cvtpk(float lo, float hi) { unsigned r; asm volatile("v_cvt_pk_bf16_f32 %0, %1, %2" : "=v"(r) : "v"(lo), "v"(hi)); return r; }
typedef __bf16 bf16x2_t __attribute__((ext_vector_type(2)));
__device__ __forceinline__ unsigned cvtpk_c(float lo, float hi) { f32x2 v = {lo, hi}; bf16x2_t b = __builtin_convertvector(v, bf16x2_t); return __builtin_bit_cast(unsigned, b); }
__device__ __forceinline__ float fsigmoid(float x) { return __builtin_amdgcn_rcpf(1.0f + __builtin_amdgcn_exp2f(x * -1.4426950408889634f)); }
template <int CTRL> __device__ __forceinline__ float dppx(float v) { return __int_as_float(__builtin_amdgcn_update_dpp(0, __float_as_int(v), CTRL, 0xf, 0xf, true)); }
__device__ __forceinline__ float xor16(float v) { return __int_as_float(__builtin_amdgcn_ds_swizzle(__float_as_int(v), 0x401F)); }
__device__ __forceinline__ float sum_xor32(float v) { auto rr = __builtin_amdgcn_permlane32_swap(__float_as_uint(v), __float_as_uint(v), false, false); return __uint_as_float(rr[0]) + __uint_as_float(rr[1]); }
__device__ __forceinline__ float red16(float v) { v += dppx<0xB1>(v); v += dppx<0x4E>(v); v += dppx<0x141>(v); v += dppx<0x140>(v); return v; }
__device__ __forceinline__ float wave_sum(float v) { v = red16(v); v += xor16(v); return sum_xor32(v); }

__device__ __forceinline__ int lane_now() { int l; asm volatile("v_mbcnt_lo_u32_b32 %0, -1, 0\n\tv_mbcnt_hi_u32_b32 %0, -1, %0" : "=v"(l)); return l; }

struct KArgs {
    const float* in[23];
    float* out;
    unsigned char* ws;
    double inv_freq[32];
};
namespace pg8 {
#define PG8_LAS __attribute__((address_space(3)))
typedef unsigned short bf16_t;
typedef short bf16x8 __attribute__((ext_vector_type(8)));
typedef float f32x4 __attribute__((ext_vector_type(4)));
typedef unsigned u32x4 __attribute__((ext_vector_type(4)));
constexpr int BM = 256, BK = 64, HALF = 128, HTB = HALF * BK * 2  , STAGE_BYTES = 8 * HTB, NXCD = 8, WGM = 8;

__host__ __device__ __forceinline__ int lds_byte(int r, int c) { const int st = (r >> 4) * 2 + (c >> 5), rr = r & 15, cc = c & 31, ob = rr * 64 + cc * 2; return st * 1024 + (ob ^ (((ob >> 9) & 1) << 5)); }
__host__ __device__ __forceinline__ void stage_rc(int b, int& R, int& C) { const int st = b / 1024, sb = b % 1024, swz = sb ^ (((sb >> 9) & 1) << 5); R = (st >> 1) * 16 + swz / 64; C = (st & 1) * 32 + (swz % 64) / 2; }
__host__ __device__ __forceinline__ int perm32(int rho) { const int n = rho >> 4, i = rho & 15; return 8 * (i >> 2) + 4 * n + (i & 3); }

struct Unit { int pm, pn; };
struct Gemm { const bf16_t* A; const bf16_t* Bt; int M, N, K, lda, ldb; };

struct StaticOrder {
    int nM, nN, nwg, G, c;
    __host__ __device__ void init(int M, int N, int G_, int c_) { nM = M / BM; nN = N / BM; nwg = nM * nN; G = G_; c = c_; }
    __host__ __device__ bool next(int i, Unit& u) const {
        const long L = (long)i * G + c; if (L >= nwg) return false;
        int wgid = (int)L; { const int q = nwg / NXCD, r = nwg % NXCD, xcd = wgid % NXCD, off = wgid / NXCD; wgid = (xcd < r ? xcd * (q + 1) : r * (q + 1) + (xcd - r) * q) + off; }
        const int nig = WGM * nN, gid = wgid / nig, fm = gid * WGM, gsz = (nM - fm) < WGM ? (nM - fm) : WGM;
        u.pm = fm + ((wgid % nig) % gsz); u.pn = (wgid % nig) / gsz; return true;
    }
    __device__ __forceinline__ void a_ready(const Unit&) const {}
    __device__ __forceinline__ void done(const Unit&) const {}
};
__device__ __forceinline__ unsigned cvt_pk_bf16(float lo, float hi) { unsigned r; asm volatile("v_cvt_pk_bf16_f32 %0, %1, %2" : "=v"(r) : "v"(lo), "v"(hi)); return r; }

__device__ __forceinline__ u32x4 pack8(f32x4 v0, f32x4 v1) { u32x4 w; w.x = cvt_pk_bf16(v0[0], v0[1]); w.y = cvt_pk_bf16(v0[2], v0[3]); w.z = cvt_pk_bf16(v1[0], v1[1]); w.w = cvt_pk_bf16(v1[2], v1[3]); return w; }
__device__ __forceinline__ void rope4(f32x4& x, f32x4 cs) {
    const float a0 = x[0] * cs[0] - x[1] * cs[1], a1 = x[0] * cs[1] + x[1] * cs[0], b0 = x[2] * cs[2] - x[3] * cs[3], b1 = x[2] * cs[3] + x[3] * cs[2];
    x = (f32x4){a0, a1, b0, b1};
}

struct EpiInProj {
    static constexpr bool PERM = true, AFTER_DRAIN = false;
    unsigned char* ws;
    __device__ __forceinline__ void operator()(const f32x4 (&acc)[2][2][4][2], const Unit& u, int wr, int wc, int fr, int fq) const {
        const int pn = u.pn, row0 = u.pm * BM + wr * 64 + fr, cin = wc * 32 + 8 * fq;
        if (pn < 22) {
            bf16_t* base; int ldc, col;
            if (pn < 4) { base = (bf16_t*)(ws + P_Q + (size_t)(pn >> 1) * 32 * MiB); ldc = 512; col = (pn & 1) * 256; }
            else if (pn < 20) { base = (bf16_t*)(ws + P_V + (size_t)((pn - 4) >> 2) * 64 * MiB); ldc = 1024; col = ((pn - 4) & 3) * 256; }
            else { base = (bf16_t*)(ws + P_CQ + (size_t)(pn - 20) * 16 * MiB); ldc = 256; col = 0; }
#pragma unroll
            for (int ai = 0; ai < 2; ++ai)
#pragma unroll
                for (int m = 0; m < 4; ++m) { bf16_t* rowp = base + (size_t)(row0 + ai * HALF + m * 16) * ldc + col + cin;
#pragma unroll
                    for (int bj = 0; bj < 2; ++bj) *(u32x4*)(rowp + bj * HALF) = pack8(acc[ai][bj][m][0], acc[ai][bj][m][1]);
                    asm volatile("" ::: "memory"); }
            if (pn >= 20) {
                float* st = (float*)(ws + WS_STAT) + (size_t)(pn - 20) * GT * 4;
#pragma unroll
                for (int ai = 0; ai < 2; ++ai)
#pragma unroll
                    for (int m = 0; m < 4; ++m) { float s = 0.f;
#pragma unroll
                        for (int bj = 0; bj < 2; ++bj)
#pragma unroll
                            for (int n = 0; n < 2; ++n) { const f32x4 x = acc[ai][bj][m][n]; s += (x[0] * x[0] + x[1] * x[1]) + (x[2] * x[2] + x[3] * x[3]); }
                        s += xor16(s); s = sum_xor32(s);
                        if (fq == 0) st[(size_t)(row0 + ai * HALF + m * 16) * 4 + wc] = s; asm volatile("" ::: "memory"); }
            }
        } else {
            if (wc == 0) {
                bf16_t* pm_ = (bf16_t*)(ws + WS_PMISC);
#pragma unroll
                for (int ai = 0; ai < 2; ++ai)
#pragma unroll
                    for (int m = 0; m < 4; ++m) *(u32x4*)(pm_ + (size_t)(row0 + ai * HALF + m * 16) * 32 + 8 * fq) = pack8(acc[ai][0][m][0], acc[ai][0][m][1]);
            } else if (wc < 3) {
                const int s0 = (wc - 1) * 32 + 8 * fq;
                const float* rt = (const float*)(ws + WS_ROPE);
                bf16_t* mk = (bf16_t*)(ws + WS_MK);
#pragma unroll
                for (int ai = 0; ai < 2; ++ai)
#pragma unroll
                    for (int m = 0; m < 4; ++m) { const int row = row0 + ai * HALF + m * 16, pos = row & (SEQ - 1);
                        const f32x4 cs0 = *(const f32x4*)(rt + (size_t)pos * 64 + s0), cs1 = *(const f32x4*)(rt + (size_t)pos * 64 + s0 + 4);
                        f32x4 v0 = acc[ai][0][m][0], v1 = acc[ai][0][m][1]; rope4(v0, cs0); rope4(v1, cs1);
                        const u32x4 w = pack8(v0, v1);
#pragma unroll
                        for (int h = 0; h < MH; ++h) *(u32x4*)(mk + (size_t)row * (MH * MQD) + h * MQD + MNOPE + s0) = w;
                        asm volatile("" ::: "memory"); }
            }
        }
    }
};

__device__ __forceinline__ float row_rstd(const float* st, int row, float invn) { const f32x4 p = *(const f32x4*)(st + (size_t)row * 4); return __builtin_amdgcn_rsqf(((p[0] + p[1]) + (p[2] + p[3])) * invn + EPS); }

struct EpiMlaQ {
    static constexpr bool PERM = true, AFTER_DRAIN = false;
    unsigned char* ws;
    __device__ __forceinline__ void operator()(const f32x4 (&acc)[2][2][4][2], const Unit& u, int wr, int wc, int fr, int fq) const {
        const int row0 = u.pm * BM + wr * 64 + fr;
        const float* rt = (const float*)(ws + WS_ROPE);
        bf16_t* mq = (bf16_t*)(ws + WS_MQ);
        const int cb0 = u.pn * BM + wc * 32 + 8 * fq, w0 = cb0 % MQD, w1 = (cb0 + HALF) % MQD;
        const int rbj = (w0 >= MNOPE) ? 0 : ((w1 >= MNOPE) ? 1 : -1);
        const int s0 = (rbj == 0 ? w0 : w1) - MNOPE;
#pragma unroll
        for (int ai = 0; ai < 2; ++ai)
#pragma unroll
            for (int mh = 0; mh < 2; ++mh) {
                f32x4 cs[2][2];
                if (rbj >= 0) {
#pragma unroll
                    for (int mm = 0; mm < 2; ++mm) { const int pos = (row0 + ai * HALF + (2 * mh + mm) * 16) & (SEQ - 1); cs[mm][0] = *(const f32x4*)(rt + (size_t)pos * 64 + s0); cs[mm][1] = *(const f32x4*)(rt + (size_t)pos * 64 + s0 + 4); }
                }
#pragma unroll
                for (int mm = 0; mm < 2; ++mm) { const int m = 2 * mh + mm, row = row0 + ai * HALF + m * 16;
#pragma unroll
                    for (int bj = 0; bj < 2; ++bj) { const int c0 = cb0 + bj * HALF;
                        f32x4 v0 = acc[ai][bj][m][0], v1 = acc[ai][bj][m][1];
                        if (bj == rbj) { rope4(v0, cs[mm][0]); rope4(v1, cs[mm][1]); }
                        *(u32x4*)(mq + (size_t)row * (MH * MQD) + c0) = pack8(v0, v1); } }
                asm volatile("" ::: "memory");
            }
    }
};

struct EpiMlaKV {
    static constexpr bool PERM = true, AFTER_DRAIN = false;
    unsigned char* ws;
    __device__ __forceinline__ void operator()(const f32x4 (&acc)[2][2][4][2], const Unit& u, int wr, int wc, int fr, int fq) const {
        const int row0 = u.pm * BM + wr * 64 + fr;
        const float* st = (const float*)(ws + WS_STAT) + (size_t)GT * 4;
        bf16_t* mk = (bf16_t*)(ws + WS_MK); bf16_t* mv = (bf16_t*)(ws + WS_MV);
#pragma unroll
        for (int ai = 0; ai < 2; ++ai) {
            f32x4 sp[4];
#pragma unroll
            for (int m = 0; m < 4; ++m) sp[m] = *(const f32x4*)(st + (size_t)(row0 + ai * HALF + m * 16) * 4);
#pragma unroll
            for (int m = 0; m < 4; ++m) { const int row = row0 + ai * HALF + m * 16; const f32x4 p = sp[m];
                const float rs = __builtin_amdgcn_rsqf(((p[0] + p[1]) + (p[2] + p[3])) * (1.0f / 256.0f) + EPS);
#pragma unroll
                for (int bj = 0; bj < 2; ++bj) { const int c0 = u.pn * BM + bj * HALF + wc * 32 + 8 * fq;
                    const u32x4 w = pack8(acc[ai][bj][m][0] * rs, acc[ai][bj][m][1] * rs);
                    if (u.pn < 4) *(u32x4*)(mk + (size_t)row * (MH * MQD) + (c0 >> 7) * MQD + (c0 & 127)) = w;
                    else *(u32x4*)(mv + (size_t)row * 1024 + (c0 - 1024)) = w; } }
            asm volatile("" ::: "memory");
        }
    }
};

template <int SECOND> struct EpiGate {
    static constexpr bool PERM = true, AFTER_DRAIN = false;
    const bf16_t* gate; bf16_t* out;
    __device__ __forceinline__ void operator()(const f32x4 (&acc)[2][2][4][2], const Unit& u, int wr, int wc, int fr, int fq) const {
        const int row0 = u.pm * BM + wr * 64 + fr, col0 = u.pn * BM + wc * 32 + 8 * fq;
#pragma unroll
        for (int ai = 0; ai < 2; ++ai)
#pragma unroll
            for (int mh = 0; mh < 2; ++mh) {
                u32x4 g[2][2], p[2][2];
#pragma unroll
                for (int mm = 0; mm < 2; ++mm)
#pragma unroll
                    for (int bj = 0; bj < 2; ++bj) { const size_t off = (size_t)(row0 + ai * HALF + (2 * mh + mm) * 16) * 1024 + col0 + bj * HALF;
                        g[mm][bj] = *(const u32x4*)(gate + off); if (SECOND) p[mm][bj] = *(const u32x4*)(out + off); }
#pragma unroll
                for (int mm = 0; mm < 2; ++mm)
#pragma unroll
                    for (int bj = 0; bj < 2; ++bj) { const int m = 2 * mh + mm; const size_t off = (size_t)(row0 + ai * HALF + m * 16) * 1024 + col0 + bj * HALF;
                        const u32x4 gg = g[mm][bj];
                        f32x4 v0 = acc[ai][bj][m][0], v1 = acc[ai][bj][m][1];
                        v0[0] *= fsigmoid(bflo(gg.x)); v0[1] *= fsigmoid(bfhi(gg.x)); v0[2] *= fsigmoid(bflo(gg.y)); v0[3] *= fsigmoid(bfhi(gg.y));
                        v1[0] *= fsigmoid(bflo(gg.z)); v1[1] *= fsigmoid(bfhi(gg.z)); v1[2] *= fsigmoid(bflo(gg.w)); v1[3] *= fsigmoid(bfhi(gg.w));
                        if (SECOND) { const u32x4 pp = p[mm][bj];
                            v0[0] += bflo(pp.x); v0[1] += bfhi(pp.x); v0[2] += bflo(pp.y); v0[3] += bfhi(pp.y); v1[0] += bflo(pp.z); v1[1] += bfhi(pp.z); v1[2] += bflo(pp.w); v1[3] += bfhi(pp.w); }
                        *(u32x4*)(out + off) = pack8(v0, v1); }
            }
    }
};

struct EpiF32 {
    static constexpr bool PERM = false, AFTER_DRAIN = false;
    float* C; int ldc;
    __device__ __forceinline__ void operator()(const f32x4 (&acc)[2][2][4][2], const Unit& u, int wr, int wc, int fr, int fq) const {
        const int row0 = u.pm * BM + wr * 64 + fr, col0 = u.pn * BM + wc * 32 + 4 * fq;
#pragma unroll
        for (int ai = 0; ai < 2; ++ai)
#pragma unroll
            for (int m = 0; m < 4; ++m) { float* rowp = C + (size_t)(row0 + ai * HALF + m * 16) * ldc + col0;
#pragma unroll
                for (int bj = 0; bj < 2; ++bj)
#pragma unroll
                    for (int n = 0; n < 2; ++n) *(f32x4*)(rowp + bj * HALF + n * 16) = acc[ai][bj][m][n]; }
    }
};

struct EpiSwiGLU {
    static constexpr bool PERM = true, AFTER_DRAIN = false;
    bf16_t* out;
    __device__ __forceinline__ void operator()(const f32x4 (&acc)[2][2][4][2], const Unit& u, int wr, int wc, int fr, int fq) const {
        const int row0 = u.pm * BM + wr * 64 + fr, oc0 = (u.pn * BM + wc * 32 + 8 * fq) >> 1;
#pragma unroll
        for (int ai = 0; ai < 2; ++ai)
#pragma unroll
            for (int m = 0; m < 4; ++m) { bf16_t* rowp = out + (size_t)(row0 + ai * HALF + m * 16) * DFF + oc0;
#pragma unroll
                for (int bj = 0; bj < 2; ++bj) { const f32x4 v0 = acc[ai][bj][m][0], v1 = acc[ai][bj][m][1];
                    const float o0 = v0[0] * fsigmoid(v0[0]) * v0[1], o1 = v0[2] * fsigmoid(v0[2]) * v0[3], o2 = v1[0] * fsigmoid(v1[0]) * v1[1], o3 = v1[2] * fsigmoid(v1[2]) * v1[3];
                    u32x2 w; w.x = cvt_pk_bf16(o0, o1); w.y = cvt_pk_bf16(o2, o3);
                    *(u32x2*)(rowp + bj * (HALF / 2)) = w; }
                asm volatile("" ::: "memory"); }
    }
};

struct EpiBf16Plain {
    static constexpr bool PERM = true, AFTER_DRAIN = false;
    bf16_t* C; int ldc;
    __device__ __forceinline__ void operator()(const f32x4 (&acc)[2][2][4][2], const Unit& u, int wr, int wc, int fr, int fq) const {
        const int row0 = u.pm * BM + wr * 64 + fr, col0 = u.pn * BM + wc * 32 + 8 * fq;
#pragma unroll
        for (int ai = 0; ai < 2; ++ai)
#pragma unroll
            for (int m = 0; m < 4; ++m) { bf16_t* rowp = C + (size_t)(row0 + ai * HALF + m * 16) * ldc + col0;
#pragma unroll
                for (int bj = 0; bj < 2; ++bj) *(u32x4*)(rowp + bj * HALF) = pack8(acc[ai][bj][m][0], acc[ai][bj][m][1]); }
    }
};
template <class Epi, class Sched, bool ALIGN_EPI = false, bool SP2 = false>
__device__ __forceinline__ void gemm_phase(PG8_LAS unsigned char* lds, const Gemm g, const Sched& S, const Epi& E, int tid_in) {
    int tid_o = tid_in; asm volatile("" : "+v"(tid_o));
    const int tid = tid_o, wid = __builtin_amdgcn_readfirstlane(tid >> 6), lane = tid & 63, wr = wid >> 2, wc = wid & 3, fr = lane & 15, fq = lane >> 4;
    const int K = g.K, nt = K / BK, lda = g.lda, ldb = g.ldb;
    unsigned voffA[2], voffB[2];
#pragma unroll
    for (int i = 0; i < 2; ++i) { int R, C; stage_rc(tid * 16 + i * 8192, R, C); const int Rb = Epi::PERM ? ((R & ~31) + perm32(R & 31)) : R;
        voffA[i] = (unsigned)(R * lda + C) * 2u; voffB[i] = (unsigned)(Rb * ldb + C) * 2u; }
    const size_t kstep = (size_t)(BK * 2);
    const size_t hsA = (size_t)HALF * lda * 2, hsB = (size_t)HALF * ldb * 2;
    const size_t tsA = 2 * hsA, tsB = 2 * hsB;
    const unsigned ldsw = (unsigned)wid * 1024u;
    const int aoff = lds_byte(wr * 64 + fr, fq * 8), boff = lds_byte(wc * 32 + fr, fq * 8);
#define PG8_SA(b, h) (((b) * 2 + (h)) * HTB)
#define PG8_SB(b, h) ((4 + (b) * 2 + (h)) * HTB)
#define PG8_STAGE(bufoff, gbase, voff) do { _Pragma("unroll") for (int _i = 0; _i < 2; ++_i) \
        __builtin_amdgcn_global_load_lds((const unsigned*)((const char*)(gbase) + (voff)[_i]), (PG8_LAS unsigned*)(lds + (bufoff) + ldsw + _i * 8192), 16, 0, 0); } while (0)
#define PG8_LDA(dst, b, h) do { _Pragma("unroll") for (int m = 0; m < 4; ++m) _Pragma("unroll") for (int k = 0; k < 2; ++k) dst[m][k] = *(const PG8_LAS bf16x8*)(lds + PG8_SA(b, h) + aoff + m * 2048 + k * 1024); } while (0)
#define PG8_LDB(dst, b, h) do { _Pragma("unroll") for (int n = 0; n < 2; ++n) _Pragma("unroll") for (int k = 0; k < 2; ++k) dst[n][k] = *(const PG8_LAS bf16x8*)(lds + PG8_SB(b, h) + boff + n * 2048 + k * 1024); } while (0)
#define PG8_MMA(ai, bj, At, Bt) do { __builtin_amdgcn_s_setprio(1); _Pragma("unroll") for (int m = 0; m < 4; ++m) _Pragma("unroll") for (int n = 0; n < 2; ++n) _Pragma("unroll") for (int k = 0; k < 2; ++k) \
        acc[ai][bj][m][n] = __builtin_amdgcn_mfma_f32_16x16x32_bf16(Bt[n][k], At[m][k], acc[ai][bj][m][n], 0, 0, 0); __builtin_amdgcn_s_setprio(0); } while (0)
#define PG8_WAIT_V(n) asm volatile("s_waitcnt vmcnt(" #n ")" ::: "memory")
#define PG8_WAIT_L(n) asm volatile("s_waitcnt lgkmcnt(" #n ")" ::: "memory")
#define PG8_BAR __builtin_amdgcn_s_barrier()
#define PG8_SCHED __builtin_amdgcn_sched_barrier(0)
    Unit cur, nxt; int ui = 0;
    if (!S.next(0, cur)) return;
    f32x4 acc[2][2][4][2];
#pragma unroll
    for (int a = 0; a < 2; ++a)
#pragma unroll
        for (int b = 0; b < 2; ++b)
#pragma unroll
            for (int m = 0; m < 4; ++m)
#pragma unroll
                for (int n = 0; n < 2; ++n) acc[a][b][m][n] = (f32x4){0.f, 0.f, 0.f, 0.f};
    bf16x8 At[4][2], B0[2][2], B1[2][2];
    const char* cA = (const char*)g.A + (size_t)cur.pm * tsA; const char* cB = (const char*)g.Bt + (size_t)cur.pn * tsB;
    S.a_ready(cur);
    if constexpr (SP2) {
        PG8_STAGE(PG8_SB(0, 0), cB, voffB); PG8_STAGE(PG8_SB(0, 1), cB + hsB, voffB); PG8_STAGE(PG8_SA(0, 0), cA, voffA); PG8_STAGE(PG8_SA(0, 1), cA + hsA, voffA);
        if (wr == 1) PG8_BAR;
        PG8_WAIT_V(2); PG8_BAR;
        PG8_STAGE(PG8_SB(1, 0), cB + kstep, voffB); PG8_STAGE(PG8_SA(1, 0), cA + kstep, voffA); PG8_STAGE(PG8_SB(1, 1), cB + hsB + kstep, voffB);
        PG8_WAIT_V(6); PG8_BAR;
    } else {
        PG8_STAGE(PG8_SB(0, 0), cB, voffB); PG8_STAGE(PG8_SA(0, 0), cA, voffA); PG8_STAGE(PG8_SB(0, 1), cB + hsB, voffB); PG8_STAGE(PG8_SA(0, 1), cA + hsA, voffA);
        if (wr == 1) PG8_BAR;
        PG8_WAIT_V(4); PG8_BAR;
        PG8_STAGE(PG8_SB(1, 0), cB + kstep, voffB); PG8_STAGE(PG8_SA(1, 0), cA + kstep, voffA); PG8_STAGE(PG8_SB(1, 1), cB + hsB + kstep, voffB);
        PG8_WAIT_V(6); PG8_BAR;
    }
    for (;;) {
        const bool has_next = S.next(ui + 1, nxt);
        const char* nA = has_next ? (const char*)g.A + (size_t)nxt.pm * tsA : cA; const char* nB = has_next ? (const char*)g.Bt + (size_t)nxt.pn * tsB : cB;
        for (int t = 0; t < nt; t += 2) {
            const bool last = (t == nt - 2);
            const char* a1 = cA + (size_t)(t + 1) * kstep;
            const char* a2 = last ? nA : cA + (size_t)(t + 2) * kstep; const char* b2 = last ? nB : cB + (size_t)(t + 2) * kstep;
            const char* a3 = a2 + kstep; const char* b3 = b2 + kstep;
            if (last && has_next) S.a_ready(nxt);
            if constexpr (SP2) {
            PG8_LDB(B0, 0, 0); PG8_LDB(B1, 0, 1); PG8_SCHED; PG8_LDA(At, 0, 0); PG8_STAGE(PG8_SA(1, 1), a1 + hsA, voffA);
            PG8_WAIT_V(8); PG8_WAIT_L(0); PG8_BAR; PG8_MMA(0, 0, At, B0); PG8_MMA(0, 1, At, B1); PG8_BAR; PG8_SCHED;
            PG8_LDA(At, 0, 1); PG8_STAGE(PG8_SB(0, 0), b2, voffB); PG8_STAGE(PG8_SB(0, 1), b2 + hsB, voffB); PG8_STAGE(PG8_SA(0, 0), a2, voffA);
            PG8_WAIT_V(8); PG8_WAIT_L(0); PG8_BAR; PG8_MMA(1, 0, At, B0); PG8_MMA(1, 1, At, B1); PG8_BAR; PG8_SCHED;
            PG8_LDB(B0, 1, 0); PG8_LDB(B1, 1, 1); PG8_SCHED; PG8_LDA(At, 1, 0); PG8_STAGE(PG8_SA(0, 1), a2 + hsA, voffA);
            PG8_WAIT_V(8); PG8_WAIT_L(0); PG8_BAR; PG8_MMA(0, 0, At, B0); PG8_MMA(0, 1, At, B1); PG8_BAR; PG8_SCHED;
            PG8_LDA(At, 1, 1); PG8_STAGE(PG8_SB(1, 0), b3, voffB); PG8_STAGE(PG8_SB(1, 1), b3 + hsB, voffB); PG8_STAGE(PG8_SA(1, 0), a3, voffA);
            PG8_WAIT_V(8); PG8_WAIT_L(0); PG8_BAR; PG8_MMA(1, 0, At, B0); PG8_MMA(1, 1, At, B1); PG8_BAR; PG8_SCHED;
            } else {
            PG8_LDB(B0, 0, 0); PG8_SCHED; PG8_LDA(At, 0, 0); PG8_STAGE(PG8_SA(1, 1), a1 + hsA, voffA);
            PG8_WAIT_L(8); PG8_BAR; PG8_WAIT_L(0); PG8_MMA(0, 0, At, B0); PG8_BAR; PG8_SCHED;
            PG8_LDB(B1, 0, 1); PG8_STAGE(PG8_SB(0, 0), b2, voffB);
            PG8_BAR; PG8_WAIT_L(0); PG8_MMA(0, 1, At, B1); PG8_BAR;
            PG8_LDA(At, 0, 1); PG8_STAGE(PG8_SA(0, 0), a2, voffA);
            PG8_BAR; PG8_WAIT_L(0); PG8_MMA(1, 0, At, B0); PG8_BAR; PG8_SCHED;
            PG8_STAGE(PG8_SB(0, 1), b2 + hsB, voffB);
            PG8_WAIT_V(6); PG8_BAR; PG8_MMA(1, 1, At, B1); PG8_BAR;
            PG8_LDB(B0, 1, 0); PG8_SCHED; PG8_LDA(At, 1, 0); PG8_STAGE(PG8_SA(0, 1), a2 + hsA, voffA);
            PG8_WAIT_L(8); PG8_BAR; PG8_WAIT_L(0); PG8_MMA(0, 0, At, B0); PG8_BAR; PG8_SCHED;
            PG8_LDB(B1, 1, 1); PG8_STAGE(PG8_SB(1, 0), b3, voffB);
            PG8_BAR; PG8_WAIT_L(0); PG8_MMA(0, 1, At, B1); PG8_BAR;
            PG8_LDA(At, 1, 1); PG8_STAGE(PG8_SA(1, 0), a3, voffA);
            PG8_BAR; PG8_WAIT_L(0); PG8_MMA(1, 0, At, B0); PG8_BAR; PG8_SCHED;
            PG8_STAGE(PG8_SB(1, 1), b3 + hsB, voffB);
            PG8_WAIT_V(6); PG8_BAR; PG8_MMA(1, 1, At, B1); PG8_BAR;
            }
        }
        if constexpr (ALIGN_EPI) { if (wr == 0) PG8_BAR; }
        if constexpr (!Epi::AFTER_DRAIN) { const int l_ = lane_now(); E(acc, cur, wr, wc, l_ & 15, l_ >> 4); S.done(cur); }
        if (!has_next) break;
#pragma unroll
        for (int a = 0; a < 2; ++a)
#pragma unroll
            for (int b = 0; b < 2; ++b)
#pragma unroll
                for (int m = 0; m < 4; ++m)
#pragma unroll
                    for (int n = 0; n < 2; ++n) acc[a][b][m][n] = (f32x4){0.f, 0.f, 0.f, 0.f};
        cur = nxt; cA = nA; cB = nB; ++ui;
        if constexpr (ALIGN_EPI) { if (wr == 1) PG8_BAR; }
    }
    PG8_WAIT_V(0);
    if constexpr (!ALIGN_EPI) { if (wr == 0) PG8_BAR; }
    PG8_BAR;
    if constexpr (Epi::AFTER_DRAIN) { E.fused(acc, cur, wr, wc, fr, fq, lds, wid, lane); S.done(cur); }
#undef PG8_SA
#undef PG8_SB
#undef PG8_STAGE
#undef PG8_LDA
#undef PG8_LDB
#undef PG8_MMA
#undef PG8_WAIT_V
#undef PG8_WAIT_L
#undef PG8_BAR
#undef PG8_SCHED
}
}

namespace attn {
constexpr int DQK = 192, DV = 128, NW = 8, QBLK = 32, KVBLK = 64;
constexpr int LDQ = MH * MQD, LDK = MH * MQD, LDV = 1024, LDO = 1024;
constexpr float SCALE = 0.07216878364870322f;
constexpr float THR = 8.f;
constexpr int SHM_V = KVBLK * DV * 2, SHM_K = KVBLK * 400, SHM_ATTN = 2 * SHM_V + 2 * SHM_K + NW * 64 * 4;
constexpr int KROW = 400;
#define KSWZ(row, colB) ((row) * KROW + (colB))
#define SBAR() __builtin_amdgcn_sched_barrier(0)
__device__ __forceinline__ int crow(int r, int hi) { return (r & 3) + 8 * (r >> 2) + 4 * hi; }

__device__ __forceinline__ void partialSM(f32x16& p0, f32x16& p1, float& m_reg, float& mn, float& alpha, const float C, const float thr) {
  float m0 = fmaxf(p0[0], p0[1]), m1 = fmaxf(p0[2], p0[3]), m2 = fmaxf(p0[4], p0[5]), m3 = fmaxf(p0[6], p0[7]);
#pragma unroll
  for (int r = 8; r < 16; r += 4) { m0 = fmaxf(m0, p0[r]); m1 = fmaxf(m1, p0[r + 1]); m2 = fmaxf(m2, p0[r + 2]); m3 = fmaxf(m3, p0[r + 3]); }
#pragma unroll
  for (int r = 0; r < 16; r += 4) { m0 = fmaxf(m0, p1[r]); m1 = fmaxf(m1, p1[r + 1]); m2 = fmaxf(m2, p1[r + 2]); m3 = fmaxf(m3, p1[r + 3]); }
  float pmax = fmaxf(fmaxf(m0, m1), fmaxf(m2, m3));
  { auto rr = __builtin_amdgcn_permlane32_swap(__float_as_uint(pmax), __float_as_uint(pmax), false, false);
    pmax = fmaxf(__uint_as_float(rr[0]), __uint_as_float(rr[1])); }
  if (__builtin_expect(__all(pmax - m_reg <= thr), 1)) { mn = m_reg; alpha = 1.f; }
  else { mn = fmaxf(m_reg, pmax); alpha = __builtin_amdgcn_exp2f((m_reg - mn) * C); m_reg = mn; }
  float mnC = -mn * C;
#pragma unroll
  for (int r = 0; r < 16; ++r) p0[r] = fmaf(p0[r], C, mnC);
#pragma unroll
  for (int r = 0; r < 16; ++r) p1[r] = fmaf(p1[r], C, mnC);
#pragma unroll
  for (int r = 0; r < 16; ++r) p0[r] = __builtin_amdgcn_exp2f(p0[r]);
}
__device__ __forceinline__ void finishSM(f32x16& p0, f32x16& p1, float alpha, float& l_reg, bf16x8& pa0, bf16x8& pa1, bf16x8& pa2, bf16x8& pa3) {
#pragma unroll
  for (int r = 0; r < 16; ++r) p1[r] = __builtin_amdgcn_exp2f(p1[r]);
  float s0 = p0[0], s1 = p0[1], s2 = p0[2], s3 = p0[3];
#pragma unroll
  for (int r = 4; r < 16; r += 4) { s0 += p0[r]; s1 += p0[r + 1]; s2 += p0[r + 2]; s3 += p0[r + 3]; }
#pragma unroll
  for (int r = 0; r < 16; r += 4) { s0 += p1[r]; s1 += p1[r + 1]; s2 += p1[r + 2]; s3 += p1[r + 3]; }
  float ps = (s0 + s1) + (s2 + s3);
  { auto rr = __builtin_amdgcn_permlane32_swap(__float_as_uint(ps), __float_as_uint(ps), false, false);
    ps = __uint_as_float(rr[0]) + __uint_as_float(rr[1]); }
  l_reg = l_reg * alpha + ps;
#define PK4(P, BASE, OUT) do { unsigned a0 = cvtpk(P[BASE + 0], P[BASE + 1]), a1 = cvtpk(P[BASE + 2], P[BASE + 3]);   \
    unsigned b0 = cvtpk(P[BASE + 4], P[BASE + 5]), b1 = cvtpk(P[BASE + 6], P[BASE + 7]);                              \
    auto r0 = __builtin_amdgcn_permlane32_swap(a0, b0, false, false); auto r1 = __builtin_amdgcn_permlane32_swap(a1, b1, false, false); \
    u32x4 w = {r0[0], r1[0], r0[1], r1[1]}; OUT = *reinterpret_cast<bf16x8*>(&w); } while (0)
  PK4(p0, 0, pa0); PK4(p0, 8, pa1); PK4(p1, 0, pa2); PK4(p1, 8, pa3);
#undef PK4
}
__device__ __forceinline__ void qkt(f32x16& p0, f32x16& p1, const char* Ks, const bf16x8* qr, int r32, int hi) {
  p0 = f32x16{}; p1 = f32x16{};
  const char* kb = Ks + r32 * KROW + hi * 16;
#pragma unroll
  for (int d0 = 0; d0 < 12; ++d0) {
    bf16x8 b0 = *reinterpret_cast<const bf16x8*>(kb + d0 * 32);
    bf16x8 b1 = *reinterpret_cast<const bf16x8*>(kb + 32 * KROW + d0 * 32);
    p0 = __builtin_amdgcn_mfma_f32_32x32x16_bf16(b0, qr[d0], p0, 0, 0, 0);
    p1 = __builtin_amdgcn_mfma_f32_32x32x16_bf16(b1, qr[d0], p1, 0, 0, 0); }
}
__device__ __forceinline__ int v_st(int k, int c) { const int kk = (k & ~0xC) | ((k & 4) << 1) | ((k & 8) >> 1); return ((kk >> 3) * 4 + (c >> 5)) * 512 + ((kk & 7) * 32 + (c & 31)) * 2; }
__device__ __forceinline__ int v_rd_base(int lane) { return ((lane & 3) << 3) | (((lane >> 2) & 3) << 6) | (((lane >> 4) & 1) << 5) | (((lane >> 5) & 1) << 8); }
constexpr int v_rd_off(int d0, int ks, int half) { return d0 * 512 + ks * 4096 + half * 2048; }
template <int OFF> __device__ __forceinline__ s16x4 tr_read(int vb) {
  s16x4 r; asm volatile("ds_read_b64_tr_b16 %0, %1 offset:%2" : "=&v"(r) : "v"(vb), "i"(OFF) : "memory"); return r;
}
#define PKLH(L, H) (bf16x8){L[0], L[1], L[2], L[3], H[0], H[1], H[2], H[3]}
template <int D0> __device__ __forceinline__ void pv_one(f32x16& od, int vb, bf16x8 pa0, bf16x8 pa1, bf16x8 pa2, bf16x8 pa3) {
  const s16x4 l0 = tr_read<v_rd_off(D0, 0, 0)>(vb), h0 = tr_read<v_rd_off(D0, 0, 1)>(vb), l1 = tr_read<v_rd_off(D0, 1, 0)>(vb), h1 = tr_read<v_rd_off(D0, 1, 1)>(vb);
  const s16x4 l2 = tr_read<v_rd_off(D0, 2, 0)>(vb), h2 = tr_read<v_rd_off(D0, 2, 1)>(vb), l3 = tr_read<v_rd_off(D0, 3, 0)>(vb), h3 = tr_read<v_rd_off(D0, 3, 1)>(vb);
  asm volatile("s_waitcnt lgkmcnt(0)" ::: "memory"); SBAR();
  od = __builtin_amdgcn_mfma_f32_32x32x16_bf16(pa0, PKLH(l0, h0), od, 0, 0, 0);
  od = __builtin_amdgcn_mfma_f32_32x32x16_bf16(pa1, PKLH(l1, h1), od, 0, 0, 0);
  od = __builtin_amdgcn_mfma_f32_32x32x16_bf16(pa2, PKLH(l2, h2), od, 0, 0, 0);
  od = __builtin_amdgcn_mfma_f32_32x32x16_bf16(pa3, PKLH(l3, h3), od, 0, 0, 0);
}
__device__ __forceinline__ void pv_d0(f32x16* o, int vb, bf16x8 pa0, bf16x8 pa1, bf16x8 pa2, bf16x8 pa3) {
  pv_one<0>(o[0], vb, pa0, pa1, pa2, pa3); pv_one<1>(o[1], vb, pa0, pa1, pa2, pa3); pv_one<2>(o[2], vb, pa0, pa1, pa2, pa3); pv_one<3>(o[3], vb, pa0, pa1, pa2, pa3);
}

__device__ __forceinline__ void attn_unit(const bf16_t* __restrict__ Qb, const bf16_t* __restrict__ Kh, const bf16_t* __restrict__ Vh, bf16_t* __restrict__ Ob, const float* __restrict__ stq, int seq, char* lds, int tid_in) {
  int tid_o = tid_in; asm volatile("" : "+v"(tid_o));
  const int tid = tid_o, wid = tid >> 6, lane = tid & 63, r32 = lane & 31, hi = lane >> 5;
  char* V_lds = lds; char* K_lds = lds + 2 * SHM_V;
  float* wsf = (float*)(lds + 2 * SHM_V + 2 * SHM_K) + wid * 64; float* li_l = wsf; float* al_l = wsf + 32;
  float m_reg = -1e30f, l_reg = 0; f32x16 o[4] = {}; bf16x8 qr[12];
  float Cl, thrl; { const f32x4 sp = *(const f32x4*)(stq + (size_t)(wid * QBLK + r32) * 4); const float rsq = 1.0f / sqrtf(((sp[0] + sp[1]) + (sp[2] + sp[3])) * (1.0f / 256.0f) + EPS);
    Cl = SCALE * 1.4426950408889634f * rsq; thrl = THR / (SCALE * rsq); }
  const bf16_t* Qw = Qb + (long)(wid * QBLK + r32) * LDQ + hi * 8;
#pragma unroll
  for (int d0 = 0; d0 < 12; ++d0) qr[d0] = *reinterpret_cast<const bf16x8*>(Qw + d0 * 16);
  const int sr = tid >> 4, sc = (tid & 15) * 8, vst0 = v_st(sr, sc), vst1 = v_st(32 + sr, sc);
  const int kr_r = tid >> 3, kr_c = 128 + (tid & 7) * 8;
  const int vb0 = (int)(uintptr_t)V_lds + v_rd_base(lane);
  bf16x8 vs0, vs1, ks0, ks1, kx0;
#define SLOAD(k0) do { const unsigned vo_ = (unsigned)((k0) + sr) * LDV + sc, ko_ = (unsigned)((k0) + sr) * LDK + sc; \
    vs0 = *(const bf16x8*)(Vh + vo_); vs1 = *(const bf16x8*)(Vh + vo_ + 32u * LDV); \
    ks0 = *(const bf16x8*)(Kh + ko_); ks1 = *(const bf16x8*)(Kh + ko_ + 32u * LDK); kx0 = *(const bf16x8*)(Kh + (unsigned)((k0) + kr_r) * LDK + kr_c); } while (0)
#define SWRITE(b) do { *(bf16x8*)(V_lds + (b) * SHM_V + vst0) = vs0; *(bf16x8*)(V_lds + (b) * SHM_V + vst1) = vs1; \
    *(bf16x8*)(K_lds + (b) * SHM_K + KSWZ(sr, sc * 2)) = ks0; *(bf16x8*)(K_lds + (b) * SHM_K + KSWZ(32 + sr, sc * 2)) = ks1; *(bf16x8*)(K_lds + (b) * SHM_K + KSWZ(kr_r, kr_c * 2)) = kx0; } while (0)
#define SWAIT() asm volatile("s_waitcnt vmcnt(0)" ::: "memory")
#define RESC(a) do { if (__any((a) < 1.f)) { if (hi == 0) al_l[r32] = (a); asm volatile("s_waitcnt lgkmcnt(0)" ::: "memory"); \
    _Pragma("unroll") for (int d = 0; d < 4; ++d) _Pragma("unroll") for (int r = 0; r < 16; ++r) o[d][r] *= al_l[crow(r, hi)]; } } while (0)
  f32x16 pA0, pA1, pB0, pB1; float mnA, mnB, alA, alB; bf16x8 pa0, pa1, pa2, pa3; const int NT = seq / KVBLK;
  SLOAD(0); SWAIT(); SWRITE(0); __syncthreads();
  qkt(pA0, pA1, K_lds, qr, r32, hi); partialSM(pA0, pA1, m_reg, mnA, alA, Cl, thrl);
  SLOAD(KVBLK);
  SWAIT(); SWRITE(1); __syncthreads();
  for (int j = 1; j + 1 < NT; j += 2) {
    SBAR(); qkt(pB0, pB1, K_lds + SHM_K, qr, r32, hi);
    finishSM(pA0, pA1, alA, l_reg, pa0, pa1, pa2, pa3); SBAR();
    SLOAD((j + 1) * KVBLK); SBAR();
    pv_d0(o, vb0, pa0, pa1, pa2, pa3); partialSM(pB0, pB1, m_reg, mnB, alB, Cl, thrl);
    __syncthreads(); SWAIT(); SWRITE(0);
    RESC(alB); __syncthreads();
    SBAR(); qkt(pA0, pA1, K_lds, qr, r32, hi);
    finishSM(pB0, pB1, alB, l_reg, pa0, pa1, pa2, pa3); SBAR();
    SLOAD((j + 2) * KVBLK); SBAR();
    pv_d0(o, vb0 + SHM_V, pa0, pa1, pa2, pa3); partialSM(pA0, pA1, m_reg, mnA, alA, Cl, thrl);
    __syncthreads(); SWAIT(); SWRITE(1);
    RESC(alA); __syncthreads();
  }
  SBAR(); qkt(pB0, pB1, K_lds + SHM_K, qr, r32, hi);
  finishSM(pA0, pA1, alA, l_reg, pa0, pa1, pa2, pa3); SBAR();
  pv_d0(o, vb0, pa0, pa1, pa2, pa3); partialSM(pB0, pB1, m_reg, mnB, alB, Cl, thrl);
  __syncthreads(); RESC(alB);
  finishSM(pB0, pB1, alB, l_reg, pa0, pa1, pa2, pa3); SBAR();
  pv_d0(o, vb0 + SHM_V, pa0, pa1, pa2, pa3);
  if (hi == 0) li_l[r32] = l_reg; asm volatile("s_waitcnt lgkmcnt(0)" ::: "memory");
  float rli[16];
#pragma unroll
  for (int r = 0; r < 16; ++r) rli[r] = __builtin_amdgcn_rcpf(li_l[crow(r, hi)]);
  bf16_t* Ow = Ob + (long)(wid * QBLK) * LDO;
#pragma unroll
  for (int r = 0; r < 16; ++r) { int orow = crow(r, hi);
#pragma unroll
    for (int d0 = 0; d0 < 4; ++d0) { const float v = o[d0][r] * rli[r]; Ow[(long)orow * LDO + d0 * 32 + r32] = (bf16_t)(cvtpk(v, v) & 0xffffu); } }
  __syncthreads();
#undef SLOAD
#undef SWRITE
#undef SWAIT
#undef RESC
}
}

namespace gla {
constexpr int RQK = 272, RKE = 144, RSC = 144;
constexpr int OFF_QD = 0, OFF_KI = 17408, OFF_KET = 34816, OFF_SC = 53248, OFF_V = 62464, OFF_DEC = 95232, OFF_AF = 95744, OFF_TOT = 99840, OFF_RQ = 101888, OFF_RK = 118272, OFF_WA = 134656, GLA_LDS = 142848;
#define A256(row, b) ((row) * RQK + (b))
#define A128(row, b) ((row) * RKE + (b))
__device__ __forceinline__ bf16_t f2bf1(float x) { return (bf16_t)(cvtpk_c(x, x) & 0xffffu); }

template <int dir>
__device__ __forceinline__ void gla_item(const bf16_t* __restrict__ PQ, const bf16_t* __restrict__ PK, const bf16_t* __restrict__ PV, const bf16_t* __restrict__ PM,
                                         const float* __restrict__ wa, const float* __restrict__ ba, bf16_t* __restrict__ GO, int b, int h, char* lds, int tid_in) {
  using attn::crow;
  int tid_o = tid_in; asm volatile("" : "+v"(tid_o));
  const int tid = tid_o, wid = tid >> 6, lane = tid & 63, r32 = lane & 31, hi = lane >> 5;
  const int d = tid & 127, jq = tid >> 7;
  { const int dd = tid >> 2, r4 = (tid & 3) * 4;
    const float w0 = wa[(r4 + 0) * GQK + h * GDK + dd], w1 = wa[(r4 + 1) * GQK + h * GDK + dd], w2 = wa[(r4 + 2) * GQK + h * GDK + dd], w3 = wa[(r4 + 3) * GQK + h * GDK + dd];
    *(u32x2*)(lds + OFF_WA + dd * 32 + r4 * 2) = (u32x2){cvtpk_c(w0, w1), cvtpk_c(w2, w3)}; }
  const float bar = ba[h * GDK + d];
  f32x16 S[4] = {};
  const int vb = (int)(uintptr_t)(lds + OFF_V) + (wid >> 2) * 16384 + (wid & 3) * 512 + attn::v_rd_base(lane);
  float* AF = (float*)(lds + OFF_AF); float* TOT = (float*)(lds + OFF_TOT); float* DEC = (float*)(lds + OFF_DEC);
  bf16x8 vreg[4], qv[2], kv[2]; unsigned afw;
#define GLA_LOAD(ROW0) do { \
    _Pragma("unroll") for (int i = 0; i < 4; ++i) { const int cid = tid + 512 * i, j = cid >> 5, ec = (cid & 31) * 8; vreg[i] = *(const bf16x8*)(PV + ((ROW0) + j) * GVW + h * GDV + ec); } \
    afw = *(const unsigned*)(PM + ((ROW0) + (tid >> 3)) * 32 + dir * 16 + (tid & 7) * 2); \
    _Pragma("unroll") for (int i = 0; i < 2; ++i) { const int cid = tid + 512 * i, j = cid >> 4, dc = (cid & 15) * 8; qv[i] = *(const bf16x8*)(PQ + ((ROW0) + j) * GQK + h * GDK + dc); kv[i] = *(const bf16x8*)(PK + ((ROW0) + j) * GQK + h * GDK + dc); } } while (0)
  { const long r00 = (long)b * SEQ + (dir ? (SEQ / GCH - 1) : 0) * GCH; GLA_LOAD(r00); }
  for (int step = 0; step < SEQ / GCH; ++step) {
    const int n = dir ? (SEQ / GCH - 1 - step) : step;
    const long row0 = (long)b * SEQ + n * GCH;
    *(unsigned*)(lds + OFF_AF + (tid >> 3) * 32 + (tid & 7) * 4) = afw;
#pragma unroll
    for (int i = 0; i < 4; ++i) { const int cid = tid + 512 * i, j = cid >> 5, ec = (cid & 31) * 8; *(bf16x8*)(lds + OFF_V + (ec >> 7) * 16384 + attn::v_st(j, ec & 127)) = vreg[i]; }
#pragma unroll
    for (int i = 0; i < 2; ++i) { const int cid = tid + 512 * i, j = cid >> 4, dc = (cid & 15) * 8; *(bf16x8*)(lds + OFF_RQ + j * 256 + dc * 2) = qv[i]; *(bf16x8*)(lds + OFF_RK + j * 256 + dc * 2) = kv[i]; }
    __syncthreads();
    { const int jt = wid >> 2, dt = wid & 3;
      const bf16x8 af_ = *(const bf16x8*)(lds + OFF_AF + (32 * jt + r32) * 32 + hi * 16), wb_ = *(const bf16x8*)(lds + OFF_WA + (32 * dt + r32) * 32 + hi * 16);
      f32x16 zt = {}; zt = __builtin_amdgcn_mfma_f32_32x32x16_bf16(af_, wb_, zt, 0, 0, 0);
      float* ZL = (float*)(lds + OFF_QD);
#pragma unroll
      for (int r = 0; r < 16; ++r) ZL[(32 * jt + crow(r, hi)) * 128 + 32 * dt + r32] = zt[r]; }
    __syncthreads();
    float la[16];
#pragma unroll
    for (int jj = 0; jj < 16; ++jj) { const float z = ((const float*)(lds + OFF_QD))[(16 * jq + jj) * 128 + d] + bar;
      la[jj] = (fminf(z, 0.f) - __builtin_amdgcn_logf(1.f + __expf(-fabsf(z))) * 0.6931471805599453f) * 0.0625f; }
    if (!dir) { float s = 0.f;
#pragma unroll
      for (int jj = 0; jj < 16; ++jj) { s += la[jj]; la[jj] = s; } }
    else { float s = 0.f;
#pragma unroll
      for (int jj = 15; jj >= 0; --jj) { s += la[jj]; la[jj] = s; } }
    TOT[jq * 128 + d] = dir ? la[0] : la[15];
    __syncthreads();
    const float t0 = TOT[d], t1 = TOT[128 + d], t2 = TOT[256 + d], t3 = TOT[384 + d];
    const float bend = (t0 + t1) + (t2 + t3);
    float off;
    if (!dir) off = (jq == 0) ? 0.f : (jq == 1) ? t0 : (jq == 2) ? (t0 + t1) : (t0 + t1 + t2);
    else      off = (jq == 3) ? 0.f : (jq == 2) ? t3 : (jq == 1) ? (t3 + t2) : (t3 + t2 + t1);
    const float ebend = __expf(bend);
    unsigned kew[8];
#pragma unroll
    for (int jp = 0; jp < 8; ++jp) { float ke2[2];
#pragma unroll
      for (int e2 = 0; e2 < 2; ++e2) { const int jj = 2 * jp + e2, j = 16 * jq + jj; const float bb = off + la[jj];
        const float qf = bf2f(*(const bf16_t*)(lds + OFF_RQ + j * 256 + 2 * d)) * 0.08838834764831845f * __expf(bb), kf = bf2f(*(const bf16_t*)(lds + OFF_RK + j * 256 + 2 * d));
        *(bf16_t*)(lds + OFF_QD + A256(j, 2 * d)) = f2bf1(qf);
        const float kiv = kf * __expf(-bb);
        *(bf16_t*)(lds + OFF_KI + A256(j, 2 * d)) = f2bf1(kiv);
        ke2[e2] = kiv * ebend; }
      kew[jp] = cvtpk_c(ke2[0], ke2[1]); }
    *(u32x4*)(lds + OFF_KET + A128(d, 32 * jq)) = (u32x4){kew[0], kew[1], kew[2], kew[3]};
    *(u32x4*)(lds + OFF_KET + A128(d, 32 * jq + 16)) = (u32x4){kew[4], kew[5], kew[6], kew[7]};
    if (jq == 0) DEC[d] = ebend;
    __syncthreads();
    if (step + 1 < SEQ / GCH) { const long rown = row0 + (dir ? -GCH : GCH); GLA_LOAD(rown); }
    if (wid < 4) {
      const int jt = wid >> 1, it = wid & 1;
      const bool dead = dir ? (jt == 0 && it == 1) : (jt == 1 && it == 0);
      f32x16 acc = {};
      if (!dead) {
#pragma unroll
        for (int ks = 0; ks < 8; ++ks) { const int cb = (16 * ks + 8 * hi) * 2;
          const bf16x8 a = *(const bf16x8*)(lds + OFF_KI + A256(32 * jt + r32, cb));
          const bf16x8 bq = *(const bf16x8*)(lds + OFF_QD + A256(32 * it + r32, cb));
          acc = __builtin_amdgcn_mfma_f32_32x32x16_bf16(a, bq, acc, 0, 0, 0); }
      }
      const int ig = 32 * it + r32;
#pragma unroll
      for (int g = 0; g < 4; ++g) { float v[4];
#pragma unroll
        for (int e = 0; e < 4; ++e) { const int jg = 32 * jt + 8 * g + 4 * hi + e; const bool keep = dir ? (jg >= ig) : (jg <= ig); v[e] = keep ? acc[4 * g + e] : 0.f; }
        u32x2 w; w.x = cvtpk_c(v[0], v[1]); w.y = cvtpk_c(v[2], v[3]);
        *(u32x2*)(lds + OFF_SC + A128(ig, (32 * jt + 8 * g + 4 * hi) * 2)) = w; }
    }
    __syncthreads();
    bf16x8 vf[4];
    { const s16x4 l0 = attn::tr_read<attn::v_rd_off(0, 0, 0)>(vb), h0 = attn::tr_read<attn::v_rd_off(0, 0, 1)>(vb), l1 = attn::tr_read<attn::v_rd_off(0, 1, 0)>(vb), h1 = attn::tr_read<attn::v_rd_off(0, 1, 1)>(vb);
      const s16x4 l2 = attn::tr_read<attn::v_rd_off(0, 2, 0)>(vb), h2 = attn::tr_read<attn::v_rd_off(0, 2, 1)>(vb), l3 = attn::tr_read<attn::v_rd_off(0, 3, 0)>(vb), h3 = attn::tr_read<attn::v_rd_off(0, 3, 1)>(vb);
      asm volatile("s_waitcnt lgkmcnt(0)" ::: "memory"); __builtin_amdgcn_sched_barrier(0);
      vf[0] = PKLH(l0, h0); vf[1] = PKLH(l1, h1); vf[2] = PKLH(l2, h2); vf[3] = PKLH(l3, h3); }
    f32x16 oa[2] = {};
#pragma unroll
    for (int dt = 0; dt < 4; ++dt)
#pragma unroll
      for (int s = 0; s < 2; ++s) {
        u32x4 sw; sw.x = cvtpk_c(S[dt][8 * s + 0], S[dt][8 * s + 1]); sw.y = cvtpk_c(S[dt][8 * s + 2], S[dt][8 * s + 3]); sw.z = cvtpk_c(S[dt][8 * s + 4], S[dt][8 * s + 5]); sw.w = cvtpk_c(S[dt][8 * s + 6], S[dt][8 * s + 7]);
        const bf16x8 sb = *reinterpret_cast<bf16x8*>(&sw);
        const int bd = 32 * dt + 16 * s;
#pragma unroll
        for (int it = 0; it < 2; ++it) { const int i = 32 * it + r32;
          const s16x4 lo = *(const s16x4*)(lds + OFF_QD + A256(i, 2 * (bd + 4 * hi))), hh = *(const s16x4*)(lds + OFF_QD + A256(i, 2 * (bd + 8 + 4 * hi)));
          oa[it] = __builtin_amdgcn_mfma_f32_32x32x16_bf16(PKLH(lo, hh), sb, oa[it], 0, 0, 0); }
      }
#pragma unroll
    for (int ks = 0; ks < 4; ++ks)
#pragma unroll
      for (int it = 0; it < 2; ++it) { const bf16x8 a = *(const bf16x8*)(lds + OFF_SC + A128(32 * it + r32, (16 * ks + 8 * hi) * 2));
        oa[it] = __builtin_amdgcn_mfma_f32_32x32x16_bf16(a, vf[ks], oa[it], 0, 0, 0); }
#pragma unroll
    for (int it = 0; it < 2; ++it)
#pragma unroll
      for (int r = 0; r < 16; ++r) { const int i = 32 * it + crow(r, hi); GO[(row0 + i) * GVW + h * GDV + 32 * wid + r32] = f2bf1(oa[it][r]); }
#pragma unroll
    for (int dt = 0; dt < 4; ++dt) {
#pragma unroll
      for (int r = 0; r < 16; ++r) S[dt][r] *= DEC[32 * dt + crow(r, hi)];
#pragma unroll
      for (int ks = 0; ks < 4; ++ks) { const bf16x8 a = *(const bf16x8*)(lds + OFF_KET + A128(32 * dt + r32, (16 * ks + 8 * hi) * 2));
        S[dt] = __builtin_amdgcn_mfma_f32_32x32x16_bf16(a, vf[ks], S[dt], 0, 0, 0); }
    }
    __syncthreads();
  }
}
#undef GLA_LOAD
}

constexpr int NWAVES = 8, NTHREADS = 512;
#ifndef REP_P2
#define REP_P2 1
#endif
#ifndef REP_P3
#define REP_P3 1
#endif
#ifndef REP_P4
#define REP_P4 1
#endif
#ifndef REP_P6
#define REP_P6 1
#endif
#ifndef REP_P7
#define REP_P7 1
#endif
#ifndef REP_P9
#define REP_P9 1
#endif
#ifndef REP_P10
#define REP_P10 1
#endif
#ifndef REP_SYNC
#define REP_SYNC 0
#endif
constexpr int LDS_BYTES = 147456;
constexpr int LDS_MISC = 143360;

enum { I_XP = 0, I_XS, I_NPRE, I_WIN, I_WAF, I_BAF, I_WAB, I_BAB, I_GNORM, I_WOGLA, I_NQ, I_WUQ, I_NKV, I_WUK, I_WUV, I_WOMLA, I_WOUT, I_NPOST, I_NFPRE, I_WGATE, I_WUP, I_WDOWN, I_NFPOST };

struct WConv { const float* W0; const float* W1; const float* scale; bf16_t* WT; int K, Nsrc, Ndst, mode; };
__device__ __forceinline__ void wsrc(const float* W0, const float* W1, int mode, int nd, const float*& W, int& col) {
    W = W0; col = nd;
    switch (mode) {
    case 0: break;
    case 1:
        if (nd < 3072) col = nd;
        else if (nd < 4096) col = 3680 + (nd - 3072);
        else if (nd < 5120) col = 4704 + (nd - 4096);
        else if (nd < 5376) col = 3104 + (nd - 5120);
        else if (nd < 5632) col = 3360 + (nd - 5376);
        else { const int j = nd - 5632; if (j < 16) col = 3072 + j; else if (j < 32) col = 3088 + (j - 16); else if (j < 96) { const int s = j - 32; col = 3616 + (s & 1) * 32 + (s >> 1); } else col = -1; }
        break;
    case 2: { const int hh = nd / MQD, w = nd % MQD; if (w >= MNOPE) { const int s = w - MNOPE; col = hh * MQD + MNOPE + (s & 1) * 32 + (s >> 1); } } break;
    case 3: if (nd >= 1024) { W = W1; col = nd - 1024; } break;
    case 4: if (nd & 1) W = W1; col = nd >> 1; break;
    }
}
__device__ __forceinline__ void wconv_item(const float* W0, const float* W1, const float* scale, bf16_t* WT, int K, int Nsrc, int Ndst, int mode, float* scr, int item, int lane) {
    const int nblk = Ndst / 32, kb = item / nblk, nb = item % nblk, k0 = 64 * kb, n0 = 32 * nb;
    const float* W; int col; wsrc(W0, W1, mode, n0 + (lane & 31), W, col);
    float wv[32];
    const int cs_ = col < 0 ? 0 : col;
#pragma unroll
    for (int i = 0; i < 32; ++i) wv[i] = W[(size_t)(k0 + 2 * i + (lane >> 5)) * Nsrc + cs_];
#pragma unroll
    for (int i = 0; i < 32; ++i) { const int kk = 2 * i + (lane >> 5); float v = col < 0 ? 0.f : wv[i]; if (scale) v *= scale[k0 + kk]; scr[kk * 33 + (lane & 31)] = v; }
    asm volatile("s_waitcnt lgkmcnt(0)" ::: "memory");
    const int cc = lane & 7;
#pragma unroll
    for (int j = 0; j < 4; ++j) { const int n = (lane >> 3) + 8 * j; const float* s = scr + (8 * cc) * 33 + n;
        u32x4 o; o.x = cvtpk(s[0 * 33], s[1 * 33]); o.y = cvtpk(s[2 * 33], s[3 * 33]); o.z = cvtpk(s[4 * 33], s[5 * 33]); o.w = cvtpk(s[6 * 33], s[7 * 33]);
        *(u32x4*)(WT + (size_t)(n0 + n) * K + k0 + 8 * cc) = o; }
    asm volatile("s_waitcnt lgkmcnt(0)" ::: "memory");
}

__device__ __forceinline__ void ld_row_f32(const float* p, int lane, f32x4 (&v)[4]) {
#pragma unroll
    for (int j = 0; j < 4; ++j) v[j] = *(const f32x4*)(p + 4 * lane + 256 * j);
}
__device__ __forceinline__ void ld_row_bf16(const bf16_t* p, int lane, f32x4 (&v)[4]) {
#pragma unroll
    for (int j = 0; j < 4; ++j) { const u32x2 w = *(const u32x2*)(p + 4 * lane + 256 * j); v[j] = (f32x4){bflo(w.x), bfhi(w.x), bflo(w.y), bfhi(w.y)}; }
}
__device__ __forceinline__ float sumsq4(const f32x4 (&v)[4]) { float s = 0.f;
#pragma unroll
    for (int j = 0; j < 4; ++j) s += (v[j][0] * v[j][0] + v[j][1] * v[j][1]) + (v[j][2] * v[j][2] + v[j][3] * v[j][3]);
    return s; }
__device__ __forceinline__ void st_row_bf16(bf16_t* p, int lane, const f32x4 (&v)[4]) {
#pragma unroll
    for (int j = 0; j < 4; ++j) { u32x2 w; w.x = cvtpk(v[j][0], v[j][1]); w.y = cvtpk(v[j][2], v[j][3]); *(u32x2*)(p + 4 * lane + 256 * j) = w; }
}


#define XB_TMO      128
#define XB_XCNT(j)  (256  + 64 * (j))
#define XB_XSUB(j)  (1280 + 64 * (j))
#define XB_XGEN(j)  (2304 + 64 * (j))
#define XB_TOP      3328
#define XB_TOPGEN   3392
#define XCD_BAR_WORDS 3456
#define XB_SPIN_CAP (1u << 23)

__device__ __forceinline__ unsigned xb_ld(unsigned* p)              { return __hip_atomic_load(p, __ATOMIC_RELAXED, __HIP_MEMORY_SCOPE_AGENT); }
__device__ __forceinline__ unsigned xb_add(unsigned* p, unsigned v) { return __hip_atomic_fetch_add(p, v, __ATOMIC_RELAXED, __HIP_MEMORY_SCOPE_AGENT); }
__device__ __forceinline__ unsigned xb_xcc_id() { return (unsigned)__builtin_amdgcn_s_getreg((3 << 11) | 20) & 0xFu; }
#define XB_SPIN(cond, bar) do { unsigned _sp = 0; while (cond) { __builtin_amdgcn_s_sleep(1); \
    if ((++_sp & 255u) == 0u) { if (xb_ld(&(bar)[XB_TMO])) break; if (_sp > XB_SPIN_CAP) { atomicAdd(&(bar)[XB_TMO], 1u); break; } } } } while (0)

struct XcdBarrier {
    unsigned* bar; unsigned x;
    volatile LAS unsigned* st;
};

__device__ __forceinline__ XcdBarrier xcd_barrier_post(unsigned* bar, volatile LAS unsigned* st) {
    XcdBarrier b; b.bar = bar; b.x = xb_xcc_id(); b.st = st;
    if (threadIdx.x == 0) (void)xb_add(&bar[XB_XCNT(b.x)], 1u);
    return b;
}
__device__ __forceinline__ void xcd_barrier_complete(unsigned* bar, unsigned x, unsigned& nloc, unsigned& nx) {
    const unsigned G = gridDim.x * gridDim.y * gridDim.z;
    unsigned sum, cnt, mine, sp = 0u;
    for (;;) {
        sum = 0u; cnt = 0u; mine = 0u;
#pragma unroll
        for (unsigned j = 0; j < 16; ++j) { const unsigned c = xb_ld(&bar[XB_XCNT(j)]); sum += c; cnt += (c > 0u) ? 1u : 0u; mine = (j == x) ? c : mine; }
        if (sum == G) break;
        __builtin_amdgcn_s_sleep(1);
        if ((++sp & 255u) == 0u) { if (xb_ld(&bar[XB_TMO])) break; if (sp > XB_SPIN_CAP) { atomicAdd(&bar[XB_TMO], 1u); break; } }
    }
    nloc = mine > 0u ? mine : 1u; nx = cnt > 0u ? cnt : 1u;
}

__device__ __forceinline__ void xcd_barrier(const XcdBarrier& b) {
    asm volatile("s_waitcnt vmcnt(0)" ::: "memory");
    __syncthreads();
    if (threadIdx.x == 0) {
        unsigned* bar = b.bar;
        __builtin_amdgcn_s_waitcnt(0);
        unsigned nloc = b.st[0], nx = b.st[1];
        if (nloc == 0u) { xcd_barrier_complete(bar, b.x, nloc, nx); b.st[0] = nloc; b.st[1] = nx; }
        const unsigned old = xb_add(&bar[XB_XSUB(b.x)], 1u);
        const unsigned gen = old / nloc;
        if (old + 1u == (gen + 1u) * nloc) {
            __builtin_amdgcn_fence(__ATOMIC_RELEASE, "agent");
            asm volatile("s_waitcnt vmcnt(0)" ::: "memory");
            const unsigned og = xb_add(&bar[XB_TOP], 1u);
            const unsigned tg = og / nx;
            if (og + 1u == (tg + 1u) * nx) xb_add(&bar[XB_TOPGEN], 1u);
            else XB_SPIN(xb_ld(&bar[XB_TOPGEN]) == tg, bar);
            __builtin_amdgcn_fence(__ATOMIC_ACQUIRE, "agent");
            xb_add(&bar[XB_XGEN(b.x)], 1u);
            asm volatile("s_waitcnt vmcnt(0)" ::: "memory");
        } else {
            XB_SPIN(xb_ld(&bar[XB_XGEN(b.x)]) == gen, bar);
            __builtin_amdgcn_fence(__ATOMIC_ACQUIRE, "agent");
            asm volatile("s_waitcnt vmcnt(0)" ::: "memory");
        }
    }
    __syncthreads();
}

#define GSYNC_CG() do { __builtin_amdgcn_fence(__ATOMIC_RELEASE, "agent"); asm volatile("s_waitcnt vmcnt(0) lgkmcnt(0)" ::: "memory"); grid.sync(); __builtin_amdgcn_fence(__ATOMIC_ACQUIRE, "agent"); asm volatile("s_waitcnt vmcnt(0)" ::: "memory"); } while (0)
#define GSYNC() xcd_barrier(xbar)
__device__ __forceinline__ int bid_now() { int b = (int)blockIdx.x; asm volatile("" : "+s"(b)); return b; }
#define TIDNOW() (wave_s * 64 + lane_now())
#define OPQ() int tid_q = TIDNOW(); asm volatile("" : "+v"(tid_q)); const int tid = tid_q, lane = tid & 63, wave = wave_s, gw = blockIdx.x * NWAVES + wave_s; (void)tid; (void)lane; (void)gw
__global__ void __launch_bounds__(NTHREADS, 2) fwd_megakernel(KArgs args) {
    extern __shared__ __attribute__((aligned(16))) unsigned char lds[];
    cg::grid_group grid = cg::this_grid();
    const int wave_s = __builtin_amdgcn_readfirstlane(threadIdx.x >> 6);
    const int tid = TIDNOW(), lane = tid & 63, wave = wave_s;
    const int G = gridDim.x, gw = blockIdx.x * NWAVES + wave, NGW = G * NWAVES;
    unsigned char* ws = args.ws;
#define in args.in
    unsigned* ctl = (unsigned*)(ws + WS_CTL);

    {
        if (blockIdx.x == 0) for (int w = tid; w < 8192; w += NTHREADS) ctl[w] = 0u;
        if (tid < 64) ((volatile LAS unsigned*)(lds + LDS_MISC))[tid] = 0u;
        float* rt = (float*)(ws + WS_ROPE);
        for (int e = blockIdx.x * NTHREADS + tid; e < SEQ * 32; e += G * NTHREADS) {
            const int pos = e >> 5, i = e & 31;
            double fq_ = 0.0;
#pragma unroll
            for (int k = 0; k < 32; ++k) fq_ = (k == i) ? args.inv_freq[k] : fq_;
            const double rev = (double)pos * fq_ * 0.15915494309189535;
            const float fr = (float)(rev - rint(rev));
            rt[2 * e] = __builtin_amdgcn_cosf(fr); rt[2 * e + 1] = __builtin_amdgcn_sinf(fr);
        }
        float* scr = (float*)(lds + wave * 16384);
#define WCONV(W0_, W1_, SC_, OFF_, K_, NS_, ND_, MODE_) do { \
            for (int it = gw; it < ((K_) / 64) * ((ND_) / 32); it += NGW) wconv_item(W0_, W1_, SC_, (bf16_t*)(ws + OFF_), K_, NS_, ND_, MODE_, scr, it, lane); } while (0)
#ifndef REP_P0
#define REP_P0 1
#endif
        for (int rp0_ = 0; rp0_ < REP_P0; ++rp0_) {
        WCONV(in[I_WIN], nullptr, nullptr, W_IN, DM, D_IN, NINP, 1);
        WCONV(in[I_WUQ], nullptr, in[I_NQ], W_UQ, MQR, MH * MQD, MH * MQD, 2);
        WCONV(in[I_WUK], in[I_WUV], in[I_NKV], W_UKV, MQR, 1024, 2048, 3);
        WCONV(in[I_WOGLA], nullptr, nullptr, W_OGLA, DM, DM, DM, 0);
        WCONV(in[I_WOMLA], nullptr, nullptr, W_OMLA, DM, DM, DM, 0);
        WCONV(in[I_WOUT], nullptr, nullptr, W_OUT, DM, DM, DM, 0);
        WCONV(in[I_WGATE], in[I_WUP], nullptr, W_GU, DM, DFF, 2 * DFF, 4);
        WCONV(in[I_WDOWN], nullptr, nullptr, W_DOWN, DFF, DM, DM, 0);
        }
#undef WCONV
    }

    XcdBarrier xbar; xbar.bar = ctl + 4096; xbar.x = 0u; xbar.st = (volatile LAS unsigned*)(lds + LDS_MISC) + 8;
    for (int grp = 0; grp < NGROUP; ++grp) {
        const size_t tok0 = (size_t)grp * GT;
        typedef __attribute__((address_space(1))) unsigned char gu8_t;
        gu8_t* wsq_ = (gu8_t*)args.ws; asm volatile("" : "+s"(wsq_));
        unsigned char* ws = (unsigned char*)wsq_;
#define WSQ() do { wsq_ = (gu8_t*)args.ws; asm volatile("" : "+s"(wsq_)); ws = (unsigned char*)wsq_; } while (0)
        const float* xg = (grp < 2) ? in[I_XP] + tok0 * DM : in[I_XS];
        float* outg = args.out + tok0 * DM;
        bf16_t* H = (bf16_t*)(ws + WS_H);
        WSQ();
        if (grp == 0) {
            OPQ();
            bf16_t* HX = (bf16_t*)(ws + WS_HX);
            f32x4 gv[4]; ld_row_f32(in[I_NPRE], lane, gv);
            { int m = gw; do { f32x4 v[4]; ld_row_f32(xg + (size_t)m * DM, lane, v);
                const float rs = 1.0f / sqrtf(wave_sum(sumsq4(v)) * (1.0f / DM) + EPS);
#pragma unroll
                for (int j = 0; j < 4; ++j) v[j] = v[j] * rs * gv[j];
                st_row_bf16(HX + (size_t)m * DM, lane, v);  m += NGW; } while (m < GT); }
            GSYNC_CG(); xbar = xcd_barrier_post(ctl + 4096, (volatile LAS unsigned*)(lds + LDS_MISC) + 8);
        }
#ifndef SKIP_MIXER
        for (int rs_ = 0; rs_ < REP_SYNC; ++rs_) GSYNC();
        WSQ();
        for (int rep_ = 0; rep_ < REP_P2; ++rep_) {
#ifndef SKIP_G0
        { pg8::Gemm g{(const bf16_t*)(ws + WS_HX), (const bf16_t*)(ws + W_IN), GT, NINP, DM, DM, DM}; pg8::StaticOrder S; S.init(GT, NINP, G, bid_now());
          pg8::EpiInProj E{ws}; pg8::gemm_phase<pg8::EpiInProj, pg8::StaticOrder, true, true>((LAS unsigned char*)lds, g, S, E, TIDNOW()); }
#endif
        GSYNC();
        }
        WSQ();
        for (int rep_ = 0; rep_ < REP_P3; ++rep_) {
#ifndef SKIP_G1
        { pg8::Gemm g{(const bf16_t*)(ws + P_CQ), (const bf16_t*)(ws + W_UQ), GT, MH * MQD, MQR, MQR, MQR}; pg8::StaticOrder S; S.init(GT, MH * MQD, G, bid_now());
          pg8::EpiMlaQ E{ws}; pg8::gemm_phase<pg8::EpiMlaQ, pg8::StaticOrder, true, true>((LAS unsigned char*)lds, g, S, E, TIDNOW()); }
#endif
#ifndef SKIP_G2
        { pg8::Gemm g{(const bf16_t*)(ws + P_CKV), (const bf16_t*)(ws + W_UKV), GT, 2048, MQR, MQR, MQR}; pg8::StaticOrder S; S.init(GT, 2048, G, bid_now());
          pg8::EpiMlaKV E{ws}; pg8::gemm_phase<pg8::EpiMlaKV, pg8::StaticOrder, true, true>((LAS unsigned char*)lds, g, S, E, TIDNOW()); }
#endif
        GSYNC();
        }
        WSQ();
        for (int rep_ = 0; rep_ < REP_P4; ++rep_) {
        {
            OPQ();
            volatile unsigned* slot = (volatile unsigned*)(lds + LDS_MISC);
#ifndef REP_GLA
#define REP_GLA 1
#endif
            constexpr int NGLA1 = GB * GH * 2, NGLA = NGLA1 * REP_GLA, NATT = GB * MH * (SEQ / 256);
            const int NP1 = (grp + 1 < NGROUP) ? GT / 64 : 0, NP11 = (grp > 0) ? GT / 64 : 0;
            for (;;) {
                if (tid == 0) *slot = atomicAdd(ctl + 64 * (grp + 3 * rep_), 1u);
                __syncthreads();
                const unsigned u = (unsigned)__builtin_amdgcn_readfirstlane((int)*slot);
                __syncthreads();
                if (u >= (unsigned)(NGLA + NATT + NP1 + NP11)) break;
                if (u < (unsigned)NGLA) {
                    const int ug = (int)(u % (unsigned)NGLA1), dir = ug & 1, h = (ug >> 1) & 3, b = ug >> 3;
#ifdef NO_GLA
                    { int t_ = TIDNOW(); asm volatile("" : "+v"(t_)); bf16_t* go = (bf16_t*)(ws + (dir ? WS_GOB : WS_GOF));
_Pragma("unroll 1") for (int e = t_; e < SEQ * GDV; e += NTHREADS) go[((size_t)b * SEQ + (e >> 8)) * GVW + h * GDV + (e & 255)] = 0; }
#else
                    if (dir) gla::gla_item<1>((const bf16_t*)(ws + P_Q), (const bf16_t*)(ws + P_K), (const bf16_t*)(ws + P_V), (const bf16_t*)(ws + WS_PMISC), in[I_WAB], in[I_BAB], (bf16_t*)(ws + WS_GOB), b, h, (char*)lds, TIDNOW());
                    else     gla::gla_item<0>((const bf16_t*)(ws + P_Q), (const bf16_t*)(ws + P_K), (const bf16_t*)(ws + P_V), (const bf16_t*)(ws + WS_PMISC), in[I_WAF], in[I_BAF], (bf16_t*)(ws + WS_GOF), b, h, (char*)lds, TIDNOW());
#endif
                } else if (u >= (unsigned)(NGLA + NATT + NP1)) {
                    const int p11 = (int)u - NGLA - NATT - NP1, l1 = lane_now();
                    float* outp = args.out + (size_t)(grp - 1) * GT * DM;
                    const bf16_t* F = (const bf16_t*)(ws + WS_F);
                    f32x4 gq[4]; ld_row_f32(in[I_NFPOST], l1, gq);
_Pragma("unroll 1") for (int k = 0; k < 8; ++k) { const int m = p11 * 64 + wave_s * 8 + k; f32x4 fv[4], xv[4]; ld_row_bf16(F + (size_t)m * DM, l1, fv); ld_row_f32(outp + (size_t)m * DM, l1, xv);
                        const float rs = 1.0f / sqrtf(wave_sum(sumsq4(fv)) * (1.0f / DM) + EPS);
_Pragma("unroll") for (int j = 0; j < 4; ++j) *(f32x4*)(outp + (size_t)m * DM + 4 * l1 + 256 * j) = xv[j] + fv[j] * rs * gq[j]; }
                } else if (u >= (unsigned)(NGLA + NATT)) {
                    const int p1 = (int)u - NGLA - NATT, l1 = lane_now();
                    const float* xn = (grp + 1 < 2) ? in[I_XP] + (size_t)(grp + 1) * GT * DM : in[I_XS];
                    bf16_t* HX = (bf16_t*)(ws + WS_HX);
                    f32x4 gv[4]; ld_row_f32(in[I_NPRE], l1, gv);
_Pragma("unroll 1") for (int k = 0; k < 8; ++k) { const int m = p1 * 64 + wave_s * 8 + k; f32x4 v[4]; ld_row_f32(xn + (size_t)m * DM, l1, v);
                        const float rs = 1.0f / sqrtf(wave_sum(sumsq4(v)) * (1.0f / DM) + EPS);
_Pragma("unroll") for (int j = 0; j < 4; ++j) v[j] = v[j] * rs * gv[j];
                        st_row_bf16(HX + (size_t)m * DM, l1, v); }
                } else {
                    const int a = u - NGLA, qb = a & 7, h = (a >> 3) & 7, b = a >> 6;
                    const size_t r0 = (size_t)b * SEQ;
#ifdef NO_ATTN
                    { int t_ = TIDNOW(); asm volatile("" : "+v"(t_)); bf16_t* mo = (bf16_t*)(ws + WS_MO) + (r0 + qb * 256) * 1024 + h * MV_;
_Pragma("unroll 1") for (int e = t_; e < 256 * 128; e += NTHREADS) mo[(size_t)(e >> 7) * 1024 + (e & 127)] = 0; }
#else
                    attn::attn_unit((const bf16_t*)(ws + WS_MQ) + (r0 + qb * 256) * (MH * MQD) + h * MQD, (const bf16_t*)(ws + WS_MK) + r0 * (MH * MQD) + h * MQD,
                                    (const bf16_t*)(ws + WS_MV) + r0 * 1024 + h * MV_, (bf16_t*)(ws + WS_MO) + (r0 + qb * 256) * 1024 + h * MV_, (const float*)(ws + WS_STAT) + (r0 + qb * 256) * 4, SEQ, (char*)lds, TIDNOW());
#endif
                }
            }
        }
        GSYNC();
        }
        WSQ();
        {
            OPQ();
            bf16_t* gof = (bf16_t*)(ws + WS_GOF); const bf16_t* gob = (const bf16_t*)(ws + WS_GOB); const bf16_t* pg = (const bf16_t*)(ws + P_G);
            float gn[16];
#pragma unroll
            for (int e = 0; e < 16; ++e) gn[e] = in[I_GNORM][(16 * lane + e) & 255];
            { int m = gw; do {
                u32x4 a0[2], a1[2], b0[2], b1[2], g0[2], g1[2];
#pragma unroll
                for (int t = 0; t < 2; ++t) { const size_t off = (size_t)(m + t * NGW) * 1024 + 16 * lane;
                    a0[t] = *(const u32x4*)(gof + off); a1[t] = *(const u32x4*)(gof + off + 8); b0[t] = *(const u32x4*)(gob + off); b1[t] = *(const u32x4*)(gob + off + 8);
                    g0[t] = *(const u32x4*)(pg + off); g1[t] = *(const u32x4*)(pg + off + 8); }
#pragma unroll
                for (int t = 0; t < 2; ++t) { const size_t off = (size_t)(m + t * NGW) * 1024 + 16 * lane;
                    float o[16], gg[16];
#pragma unroll
                    for (int q = 0; q < 4; ++q) { o[2 * q] = bflo(a0[t][q]) + bflo(b0[t][q]); o[2 * q + 1] = bfhi(a0[t][q]) + bfhi(b0[t][q]); o[8 + 2 * q] = bflo(a1[t][q]) + bflo(b1[t][q]); o[8 + 2 * q + 1] = bfhi(a1[t][q]) + bfhi(b1[t][q]);
                        gg[2 * q] = bflo(g0[t][q]); gg[2 * q + 1] = bfhi(g0[t][q]); gg[8 + 2 * q] = bflo(g1[t][q]); gg[8 + 2 * q + 1] = bfhi(g1[t][q]); }
                    float s = 0.f;
#pragma unroll
                    for (int e = 0; e < 16; ++e) s += o[e] * o[e];
                    s = red16(s);
                    const float rs = 1.0f / sqrtf(s * (1.0f / GDV) + EPS);
#pragma unroll
                    for (int e = 0; e < 16; ++e) o[e] = o[e] * rs * gn[e] * (gg[e] * fsigmoid(gg[e]));
                    u32x4 w0, w1;
#pragma unroll
                    for (int q = 0; q < 4; ++q) { w0[q] = cvtpk(o[2 * q], o[2 * q + 1]); w1[q] = cvtpk(o[8 + 2 * q], o[8 + 2 * q + 1]); }
                    *(u32x4*)(gof + off) = w0; *(u32x4*)(gof + off + 8) = w1; }
                m += 2 * NGW; } while (m < GT); }
        }
        GSYNC();
        WSQ();
        for (int rep_ = 0; rep_ < REP_P6; ++rep_) {
#ifndef SKIP_G3
        { pg8::Gemm g{(const bf16_t*)(ws + WS_GOF), (const bf16_t*)(ws + W_OGLA), GT, DM, DM, DM, DM}; pg8::StaticOrder S; S.init(GT, DM, G, bid_now());
          pg8::EpiGate<0> E{(const bf16_t*)(ws + P_GA), (bf16_t*)(ws + WS_MERGED)}; pg8::gemm_phase<pg8::EpiGate<0>, pg8::StaticOrder, true, true>((LAS unsigned char*)lds, g, S, E, TIDNOW()); }
#endif
#ifndef SKIP_G4
        { pg8::Gemm g{(const bf16_t*)(ws + WS_MO), (const bf16_t*)(ws + W_OMLA), GT, DM, DM, DM, DM}; pg8::StaticOrder S; S.init(GT, DM, G, bid_now());
          pg8::EpiGate<1> E{(const bf16_t*)(ws + P_GB), (bf16_t*)(ws + WS_MERGED)}; pg8::gemm_phase<pg8::EpiGate<1>, pg8::StaticOrder, true, true>((LAS unsigned char*)lds, g, S, E, TIDNOW()); }
#endif
        GSYNC();
        }
        WSQ();
        for (int rep_ = 0; rep_ < REP_P7; ++rep_) {
#ifndef SKIP_G5
        { pg8::Gemm g{(const bf16_t*)(ws + WS_MERGED), (const bf16_t*)(ws + W_OUT), GT, DM, DM, DM, DM}; pg8::StaticOrder S; S.init(GT, DM, G, bid_now());
          pg8::EpiBf16Plain E{(bf16_t*)(ws + WS_U), DM}; pg8::gemm_phase<pg8::EpiBf16Plain, pg8::StaticOrder, true, true>((LAS unsigned char*)lds, g, S, E, TIDNOW()); }
#endif
        GSYNC();
        }
#endif
        WSQ();
        {
            OPQ();
            f32x4 gp[4], gf[4]; ld_row_f32(in[I_NPOST], lane, gp); ld_row_f32(in[I_NFPRE], lane, gf);
            const bf16_t* U = (const bf16_t*)(ws + WS_U);
            { int m = gw; do { f32x4 uv[4][4], xv[4][4];
#pragma unroll
                for (int t = 0; t < 4; ++t) { ld_row_bf16(U + (size_t)(m + t * NGW) * DM, lane, uv[t]); ld_row_f32(xg + (size_t)(m + t * NGW) * DM, lane, xv[t]); }
#pragma unroll
                for (int t = 0; t < 4; ++t) { const size_t mm = (size_t)(m + t * NGW);
#ifdef SKIP_MIXER
                    for (int j = 0; j < 4; ++j) uv[t][j] = (f32x4){0.f, 0.f, 0.f, 0.f};
#endif
                    const float rs = 1.0f / sqrtf(wave_sum(sumsq4(uv[t])) * (1.0f / DM) + EPS);
#pragma unroll
                    for (int j = 0; j < 4; ++j) xv[t][j] = xv[t][j] + uv[t][j] * rs * gp[j];
#pragma unroll
                    for (int j = 0; j < 4; ++j) *(f32x4*)(outg + mm * DM + 4 * lane + 256 * j) = xv[t][j];
                    const float rs2 = 1.0f / sqrtf(wave_sum(sumsq4(xv[t])) * (1.0f / DM) + EPS);
#pragma unroll
                    for (int j = 0; j < 4; ++j) xv[t][j] = xv[t][j] * rs2 * gf[j];
                    st_row_bf16(H + mm * DM, lane, xv[t]); }
                m += 4 * NGW; } while (m < GT); }
        }
        GSYNC();
        WSQ();
        for (int rep_ = 0; rep_ < REP_P9; ++rep_) {
#ifndef SKIP_G6
        { pg8::Gemm g{H, (const bf16_t*)(ws + W_GU), GT, 2 * DFF, DM, DM, DM}; pg8::StaticOrder S; S.init(GT, 2 * DFF, G, bid_now());
          pg8::EpiSwiGLU E{(bf16_t*)(ws + WS_A)}; pg8::gemm_phase<pg8::EpiSwiGLU, pg8::StaticOrder, true, true>((LAS unsigned char*)lds, g, S, E, TIDNOW()); }
#endif
        GSYNC();
        }
        WSQ();
        for (int rep_ = 0; rep_ < REP_P10; ++rep_) {
#ifndef SKIP_G7
        { pg8::Gemm g{(const bf16_t*)(ws + WS_A), (const bf16_t*)(ws + W_DOWN), GT, DM, DFF, DFF, DFF}; pg8::StaticOrder S; S.init(GT, DM, G, bid_now());
          pg8::EpiBf16Plain E{(bf16_t*)(ws + WS_F), DM}; pg8::gemm_phase<pg8::EpiBf16Plain, pg8::StaticOrder, true, true>((LAS unsigned char*)lds, g, S, E, TIDNOW()); }
#endif
        GSYNC();
        }
        WSQ();
        if (grp == NGROUP - 1) {
            OPQ();
            f32x4 gq[4]; ld_row_f32(in[I_NFPOST], lane, gq);
            const bf16_t* F = (const bf16_t*)(ws + WS_F);
            { int m = gw; do { f32x4 fv[4], xv[4]; ld_row_bf16(F + (size_t)m * DM, lane, fv); ld_row_f32(outg + (size_t)m * DM, lane, xv);
                const float rs = 1.0f / sqrtf(wave_sum(sumsq4(fv)) * (1.0f / DM) + EPS);
#pragma unroll
                for (int j = 0; j < 4; ++j) *(f32x4*)(outg + (size_t)m * DM + 4 * lane + 256 * j) = xv[j] + fv[j] * rs * gq[j];  m += NGW; } while (m < GT); }
        }
    }
}

#undef in
extern "C" void kernel_launch(void* const* d_in, const int* in_sizes, int n_in, void* d_out, int out_size, void* d_ws, size_t ws_size, hipStream_t stream) {
    static int grid = 0;
    if (grid == 0) {
        if (n_in != 23 || out_size != TTOT * DM || ws_size < WS_END) { fprintf(stderr, "kernel_launch: unexpected shapes n_in %d out %d ws %zu\n", n_in, out_size, ws_size); grid = -1; return; }
        int dev = 0, cus = 0, per_cu = 0;
        hipGetDevice(&dev); hipDeviceGetAttribute(&cus, hipDeviceAttributeMultiprocessorCount, dev);
        if (hipFuncSetAttribute((const void*)fwd_megakernel, hipFuncAttributeMaxDynamicSharedMemorySize, LDS_BYTES) != hipSuccess) { fprintf(stderr, "kernel_launch: hipFuncSetAttribute failed\n"); grid = -1; return; }
        if (hipOccupancyMaxActiveBlocksPerMultiprocessor(&per_cu, (const void*)fwd_megakernel, NTHREADS, LDS_BYTES) != hipSuccess || per_cu < 1) { fprintf(stderr, "kernel_launch: occupancy query %d\n", per_cu); per_cu = 1; }
        (void)hipGetLastError();
        grid = cus * 1;
    }
    if (grid < 0) return;
    KArgs a{};
    for (int i = 0; i < 23; ++i) a.in[i] = (const float*)d_in[i];
    a.out = (float*)d_out; a.ws = (unsigned char*)d_ws;
    for (int i = 0; i < 32; ++i) a.inv_freq[i] = pow(10000.0, -(double)(2 * i) / 64.0);
    void* kargs[] = {&a};
    hipError_t e = hipLaunchCooperativeKernel((const void*)fwd_megakernel, dim3(grid), dim3(NTHREADS), kargs, LDS_BYTES, stream);
    if (e != hipSuccess) fprintf(stderr, "kernel_launch: cooperative launch failed: %s (grid %d)\n", hipGetErrorString(e), grid);
}
```
